# Optimizing an MI355X kernel written in HIP

```python
import jax, jax.numpy as jnp
from jax import lax
import numpy as np

D_MODEL = 1024
BATCH = 16
SEQ = 2048
DEPTH = 1
DEC_BATCH = 16
DEC_SEQ = 64
PAST_LEN = 1024

CHUNK = 64
D_MIX = 2 * D_MODEL
D_POOL = D_MIX // 2
POOL_WINDOWS = (2, 4, 8, 16)
N_POOL_GROUPS = len(POOL_WINDOWS)
POOL_GROUP = D_POOL // N_POOL_GROUPS
POOL_HIST = max(POOL_WINDOWS) - 1
D_GLA_V = D_MIX - D_POOL
D_GLA_K = D_GLA_V // 2
N_GLA_HEADS = 4
HEAD_K = D_GLA_K // N_GLA_HEADS
HEAD_V = D_GLA_V // N_GLA_HEADS
GATE_RANK = 16
GATE_NORM = 16.0
GLA_CHUNK = CHUNK
EPS = 1e-6
D_IN_PROJ = 2 * D_POOL + 2 * D_GLA_K + 2 * D_GLA_V + GATE_RANK

kernel_name = "hybrid_pool_gla_stream_step"


def _rmsnorm(x, g):
    xf = x.astype(jnp.float32)
    y = xf * lax.rsqrt(jnp.mean(xf * xf, axis=-1, keepdims=True) + EPS)
    return y * g.astype(jnp.float32)


def _pool_mix(u_ext, pos0, w_pool, pool_scale):
    B, L, _ = u_ext.shape
    T = L - POOL_HIST
    uf = u_ext.astype(jnp.float32)
    cs = jnp.concatenate([jnp.zeros((B, 1, D_POOL), jnp.float32), jnp.cumsum(uf, axis=1)], axis=1)
    end = cs[:, POOL_HIST + 1:]
    u_t = uf[:, POOL_HIST:]
    pos = pos0 + jnp.arange(T, dtype=jnp.int32)
    parts = []
    for gi, w in enumerate(POOL_WINDOWS):
        sl = slice(gi * POOL_GROUP, (gi + 1) * POOL_GROUP)
        start = cs[:, POOL_HIST + 1 - w: POOL_HIST + 1 - w + T, sl]
        cnt = jnp.minimum(w, pos + 1).astype(jnp.float32)[None, :, None]
        parts.append((end[..., sl] - start) / cnt - u_t[..., sl])
    p = jnp.stack(parts, axis=2)
    y = jnp.einsum('btgc,gcd->btgd', p, w_pool.astype(jnp.float32)).reshape(B, T, D_POOL)
    return y * pool_scale.astype(jnp.float32)


def _gla(q, k, v, log_a, s0):
    B, T, H, _ = q.shape
    n = -(-T // GLA_CHUNK)
    pad = n * GLA_CHUNK - T

    def blocks(a):
        a = jnp.pad(a, ((0, 0), (0, pad), (0, 0), (0, 0)))
        return a.reshape(B, n, GLA_CHUNK, H, a.shape[-1]).transpose(1, 0, 3, 2, 4)

    xs = (blocks(q), blocks(k), blocks(v), blocks(log_a))
    causal = jnp.tril(jnp.ones((GLA_CHUNK, GLA_CHUNK), bool))[:, :, None]

    def step(S, inp):
        qc, kc, vc, gc = inp
        b = jnp.cumsum(gc, axis=2)
        diff = b[:, :, :, None, :] - b[:, :, None, :, :]
        decay = jnp.exp(jnp.where(causal, diff, -jnp.inf))
        scores = jnp.einsum('bhik,bhijk,bhjk->bhij', qc, decay, kc)
        o = (jnp.einsum('bhij,bhjv->bhiv', scores, vc)
             + jnp.einsum('bhik,bhkv->bhiv', qc * jnp.exp(b), S))
        b_end = b[:, :, -1, :]
        k_dec = kc * jnp.exp(b_end[:, :, None, :] - b)
        S = jnp.exp(b_end)[..., None] * S + jnp.einsum('bhjk,bhjv->bhkv', k_dec, vc)
        return S, o

    S, o = lax.scan(step, s0, xs)
    o = o.transpose(1, 0, 3, 2, 4).reshape(B, n * GLA_CHUNK, H, HEAD_V)[:, :T]
    return o, S


def _layer(x, pool_hist, gla_state, pos0, g_pre, w_in, w_gate_up, b_gate_up,
           w_pool, pool_scale, g_gla_out, w_out, g_post):
    B, T, _ = x.shape
    h = _rmsnorm(x, g_pre)
    z = h @ w_in.astype(jnp.float32)
    o1 = D_POOL
    o2 = o1 + D_POOL
    o3 = o2 + D_GLA_K
    o4 = o3 + D_GLA_K
    o5 = o4 + D_GLA_V
    o6 = o5 + D_GLA_V
    u_pool, gate_pool = z[..., :o1], z[..., o1:o2]
    q, k, v = z[..., o2:o3], z[..., o3:o4], z[..., o4:o5]
    gate_gla, g_lr = z[..., o5:o6], z[..., o6:]

    u_ext = jnp.concatenate([pool_hist.astype(jnp.float32), u_pool], axis=1)
    y_pool = _pool_mix(u_ext, pos0, w_pool, pool_scale) * jax.nn.silu(gate_pool)

    gk = g_lr @ w_gate_up.astype(jnp.float32) + b_gate_up.astype(jnp.float32)
    log_a = (jax.nn.log_sigmoid(gk) / GATE_NORM).reshape(B, T, N_GLA_HEADS, HEAD_K)
    qh = q.reshape(B, T, N_GLA_HEADS, HEAD_K) * (HEAD_K ** -0.5)
    kh = k.reshape(B, T, N_GLA_HEADS, HEAD_K)
    vh = v.reshape(B, T, N_GLA_HEADS, HEAD_V)
    o, S = _gla(qh, kh, vh, log_a, gla_state.astype(jnp.float32))
    o = _rmsnorm(o, g_gla_out).reshape(B, T, D_GLA_V)
    y_gla = o * jax.nn.silu(gate_gla)

    y = jnp.concatenate([y_pool, y_gla], axis=-1) @ w_out.astype(jnp.float32)
    x_new = (x.astype(jnp.float32) + _rmsnorm(y, g_post)).astype(x.dtype)
    new_hist = u_ext[:, -POOL_HIST:].astype(x.dtype)
    return x_new, new_hist, S.astype(x.dtype)


def setup_inputs(seed: int = 0) -> dict:
    key = jax.random.key(seed)
    ks = jax.random.split(key, 14)
    f32 = jnp.float32
    return {
        "x_prompt": jax.random.normal(ks[0], (BATCH, SEQ, D_MODEL), f32),
        "x_sample": jax.random.normal(ks[1], (DEC_BATCH, DEC_SEQ, D_MODEL), f32),
        "state_pool": jax.random.normal(ks[2], (DEPTH, DEC_BATCH, POOL_HIST, D_POOL), f32),
        "state_gla": 0.5 * jax.random.normal(ks[3], (DEPTH, DEC_BATCH, N_GLA_HEADS, HEAD_K, HEAD_V), f32),
        "g_pre": 1.0 + 0.02 * jax.random.normal(ks[4], (DEPTH, D_MODEL), f32),
        "w_in": jax.random.normal(ks[5], (DEPTH, D_MODEL, D_IN_PROJ), f32) * D_MODEL ** -0.5,
        "w_gate_up": jax.random.normal(ks[6], (DEPTH, GATE_RANK, D_GLA_K), f32) * GATE_RANK ** -0.5,
        "b_gate_up": 0.1 * jax.random.normal(ks[7], (DEPTH, D_GLA_K), f32),
        "w_pool": jax.random.normal(ks[8], (DEPTH, N_POOL_GROUPS, POOL_GROUP, POOL_GROUP), f32) * POOL_GROUP ** -0.5,
        "pool_scale": 1.0 + 0.02 * jax.random.normal(ks[9], (DEPTH, D_POOL), f32),
        "g_gla_out": 1.0 + 0.02 * jax.random.normal(ks[10], (DEPTH, HEAD_V), f32),
        "w_out": jax.random.normal(ks[11], (DEPTH, D_MIX, D_MODEL), f32) * D_MIX ** -0.5,
        "g_post": 1.0 + 0.02 * jax.random.normal(ks[12], (DEPTH, D_MODEL), f32),
    }


def reference(x_prompt, x_sample, state_pool, state_gla, g_pre, w_in, w_gate_up, b_gate_up,
              w_pool, pool_scale, g_gla_out, w_out, g_post):
    hp, hs = x_prompt, x_sample
    pool_p, gla_p, pool_s, gla_s = [], [], [], []
    for l in range(DEPTH):
        w = (g_pre[l], w_in[l], w_gate_up[l], b_gate_up[l], w_pool[l], pool_scale[l],
             g_gla_out[l], w_out[l], g_post[l])
        zero_hist = jnp.zeros((hp.shape[0], POOL_HIST, D_POOL), hp.dtype)
        zero_state = jnp.zeros((hp.shape[0], N_GLA_HEADS, HEAD_K, HEAD_V), jnp.float32)
        hp, ph, ps = _layer(hp, zero_hist, zero_state, 0, *w)
        hs, sh, ss = _layer(hs, state_pool[l], state_gla[l], PAST_LEN, *w)
        pool_p.append(ph)
        gla_p.append(ps)
        pool_s.append(sh)
        gla_s.append(ss)
    new_pool_prompt = jnp.stack(pool_p)
    new_gla_prompt = jnp.stack(gla_p)
    new_pool_sample = jnp.stack(pool_s)
    new_gla_sample = jnp.stack(gla_s)
    return (hp, hs, new_pool_prompt, new_gla_prompt, new_pool_sample, new_gla_sample)
```

```cpp
#include <hip/hip_runtime.h>
#include <hip/hip_cooperative_groups.h>
#include <cstdio>
#include <cstdint>
namespace cg = cooperative_groups;

#ifndef MK_N_LAUNCHES
#define MK_N_LAUNCHES 6
#endif

namespace pg8 {
#define PG8_LAS __attribute__((address_space(3)))
typedef unsigned short bf16_t;
typedef short bf16x8 __attribute__((ext_vector_type(8)));
typedef float f32x4 __attribute__((ext_vector_type(4)));
typedef unsigned u32x4 __attribute__((ext_vector_type(4)));
constexpr int BM = 256, BK = 64, HALF = 128, HTB = HALF * BK * 2  , STAGE_BYTES = 8 * HTB, NXCD = 8, WGM = 8;

__host__ __device__ __forceinline__ int lds_byte(int r, int c) { const int st = (r >> 4) * 2 + (c >> 5), rr = r & 15, cc = c & 31, ob = rr * 64 + cc * 2; return st * 1024 + (ob ^ (((ob >> 9) & 1) << 5)); }
__host__ __device__ __forceinline__ void stage_rc(int b, int& R, int& C) { const int st = b / 1024, sb = b % 1024, swz = sb ^ (((sb >> 9) & 1) << 5); R = (st >> 1) * 16 + swz / 64; C = (st & 1) * 32 + (swz % 64) / 2; }
__host__ __device__ __forceinline__ int perm32(int rho) { const int n = rho >> 4, i = rho & 15; return 8 * (i >> 2) + 4 * n + (i & 3); }

struct Unit { int pm, pn; };
struct Gemm { const bf16_t* A; const bf16_t* Bt; int lda, ldb, K, aShift; };

struct StaticOrder {
    int nM, nN, nwg, G, c;
    __host__ __device__ void init(int nM_, int nN_, int G_, int c_) { nM = nM_; nN = nN_; nwg = nM * nN; G = G_; c = c_; }
    __host__ __device__ bool next(int i, Unit& u) const {
        const long L = (long)i * G + c; if (L >= nwg) return false;
        int wgid = (int)L; { const int q = nwg / NXCD, r = nwg % NXCD, xcd = wgid % NXCD, off = wgid / NXCD; wgid = (xcd < r ? xcd * (q + 1) : r * (q + 1) + (xcd - r) * q) + off; }
        const int nig = WGM * nN, gid = wgid / nig, fm = gid * WGM, gsz = (nM - fm) < WGM ? (nM - fm) : WGM;
        u.pm = fm + ((wgid % nig) % gsz); u.pn = (wgid % nig) / gsz; return true;
    }
};

__device__ __forceinline__ unsigned cvt_pk_bf16(float lo, float hi) { unsigned r; asm volatile("v_cvt_pk_bf16_f32 %0, %1, %2" : "=v"(r) : "v"(lo), "v"(hi)); return r; }

template <class Epi, class Sched, bool ALIGN_EPI>
__device__ __forceinline__ void gemm_phase(PG8_LAS unsigned char* lds, const Gemm g, const Sched& S, const Epi& E) {
    const int tid = threadIdx.x, wid = __builtin_amdgcn_readfirstlane(tid >> 6), lane = tid & 63, wr = wid >> 2, wc = wid & 3, fr = lane & 15, fq = lane >> 4;
    const int K = g.K, nt = K / BK;
    unsigned voffA[2], voffB[2];
#pragma unroll
    for (int i = 0; i < 2; ++i) { int R, C; stage_rc(tid * 16 + i * 8192, R, C); const int Rb = Epi::PERM ? ((R & ~31) + perm32(R & 31)) : R;
        voffA[i] = (unsigned)(R * g.lda + C) * 2u; voffB[i] = (unsigned)(Rb * g.ldb + C) * 2u; }
    const size_t kstep = (size_t)(BK * 2);
    const size_t hstepA = (size_t)HALF * g.lda * 2, hstepB = (size_t)HALF * g.ldb * 2;
    const size_t tstepA = 2 * hstepA, tstepB = 2 * hstepB;
    const unsigned ldsw = (unsigned)wid * 1024u;
    const int aoff = lds_byte(wr * 64 + fr, fq * 8), boff = lds_byte(wc * 32 + fr, fq * 8);
#define PG8_SA(b, h) (((b) * 2 + (h)) * HTB)
#define PG8_SB(b, h) ((4 + (b) * 2 + (h)) * HTB)
#define PG8_STAGE(bufoff, gbase, voff) do { _Pragma("unroll") for (int _i = 0; _i < 2; ++_i) \
        __builtin_amdgcn_global_load_lds((const unsigned*)((const char*)(gbase) + (voff)[_i]), (PG8_LAS unsigned*)(lds + (bufoff) + ldsw + _i * 8192), 16, 0, 0); } while (0)
#define PG8_LDA(dst, b, h) do { _Pragma("unroll") for (int m = 0; m < 4; ++m) _Pragma("unroll") for (int k = 0; k < 2; ++k) dst[m][k] = *(const PG8_LAS bf16x8*)(lds + PG8_SA(b, h) + aoff + m * 2048 + k * 1024); } while (0)
#define PG8_LDB(dst, b, h) do { _Pragma("unroll") for (int n = 0; n < 2; ++n) _Pragma("unroll") for (int k = 0; k < 2; ++k) dst[n][k] = *(const PG8_LAS bf16x8*)(lds + PG8_SB(b, h) + boff + n * 2048 + k * 1024); } while (0)
#define PG8_MMA(ai, bj, At, Bt) do { __builtin_amdgcn_s_setprio(1); _Pragma("unroll") for (int m = 0; m < 4; ++m) _Pragma("unroll") for (int n = 0; n < 2; ++n) _Pragma("unroll") for (int k = 0; k < 2; ++k) \
        acc[ai][bj][m][n] = __builtin_amdgcn_mfma_f32_16x16x32_bf16(Bt[n][k], At[m][k], acc[ai][bj][m][n], 0, 0, 0); __builtin_amdgcn_s_setprio(0); } while (0)
#define PG8_WAIT_V(n) asm volatile("s_waitcnt vmcnt(" #n ")" ::: "memory")
#define PG8_WAIT_L(n) asm volatile("s_waitcnt lgkmcnt(" #n ")" ::: "memory")
#define PG8_BAR __builtin_amdgcn_s_barrier()
#define PG8_SCHED __builtin_amdgcn_sched_barrier(0)
    Unit cur, nxt; int ui = 0;
    if (!S.next(0, cur)) return;
    f32x4 acc[2][2][4][2];
#pragma unroll
    for (int a = 0; a < 2; ++a)
#pragma unroll
        for (int b = 0; b < 2; ++b)
#pragma unroll
            for (int m = 0; m < 4; ++m)
#pragma unroll
                for (int n = 0; n < 2; ++n) acc[a][b][m][n] = (f32x4){0.f, 0.f, 0.f, 0.f};
    bf16x8 At[4][2], B0[2][2], B1[2][2];
    const char* cA = (const char*)g.A + (size_t)cur.pm * tstepA + (size_t)cur.pn * g.aShift; const char* cB = (const char*)g.Bt + (size_t)cur.pn * tstepB;
    PG8_STAGE(PG8_SB(0, 0), cB, voffB); PG8_STAGE(PG8_SB(0, 1), cB + hstepB, voffB); PG8_STAGE(PG8_SA(0, 0), cA, voffA); PG8_STAGE(PG8_SA(0, 1), cA + hstepA, voffA);
    if (wr == 1) PG8_BAR;
    PG8_WAIT_V(2); PG8_BAR;
    PG8_STAGE(PG8_SB(1, 0), cB + kstep, voffB); PG8_STAGE(PG8_SA(1, 0), cA + kstep, voffA); PG8_STAGE(PG8_SB(1, 1), cB + hstepB + kstep, voffB);
    PG8_WAIT_V(6); PG8_BAR;
    for (;;) {
        const bool has_next = S.next(ui + 1, nxt);
        const char* nA = has_next ? (const char*)g.A + (size_t)nxt.pm * tstepA + (size_t)nxt.pn * g.aShift : cA; const char* nB = has_next ? (const char*)g.Bt + (size_t)nxt.pn * tstepB : cB;
        for (int t = 0; t < nt; t += 2) {
            const bool last = (t == nt - 2);
            const char* a1 = cA + (size_t)(t + 1) * kstep;
            const char* a2 = last ? nA : cA + (size_t)(t + 2) * kstep; const char* b2 = last ? nB : cB + (size_t)(t + 2) * kstep;
            const char* a3 = a2 + kstep; const char* b3 = b2 + kstep;
            PG8_LDB(B0, 0, 0); PG8_LDB(B1, 0, 1); PG8_SCHED; PG8_LDA(At, 0, 0); PG8_STAGE(PG8_SA(1, 1), a1 + hstepA, voffA);
            PG8_WAIT_V(8); PG8_WAIT_L(0); PG8_BAR; PG8_MMA(0, 0, At, B0); PG8_MMA(0, 1, At, B1); PG8_BAR; PG8_SCHED;
            PG8_LDA(At, 0, 1); PG8_STAGE(PG8_SB(0, 0), b2, voffB); PG8_STAGE(PG8_SB(0, 1), b2 + hstepB, voffB); PG8_STAGE(PG8_SA(0, 0), a2, voffA);
            PG8_WAIT_V(8); PG8_WAIT_L(0); PG8_BAR; PG8_MMA(1, 0, At, B0); PG8_MMA(1, 1, At, B1); PG8_BAR; PG8_SCHED;
            PG8_LDB(B0, 1, 0); PG8_LDB(B1, 1, 1); PG8_SCHED; PG8_LDA(At, 1, 0); PG8_STAGE(PG8_SA(0, 1), a2 + hstepA, voffA);
            PG8_WAIT_V(8); PG8_WAIT_L(0); PG8_BAR; PG8_MMA(0, 0, At, B0); PG8_MMA(0, 1, At, B1); PG8_BAR; PG8_SCHED;
            PG8_LDA(At, 1, 1); PG8_STAGE(PG8_SB(1, 0), b3, voffB); PG8_STAGE(PG8_SB(1, 1), b3 + hstepB, voffB); PG8_STAGE(PG8_SA(1, 0), a3, voffA);
            PG8_WAIT_V(8); PG8_WAIT_L(0); PG8_BAR; PG8_MMA(1, 0, At, B0); PG8_MMA(1, 1, At, B1); PG8_BAR; PG8_SCHED;
        }
        if constexpr (ALIGN_EPI) { if (wr == 0) PG8_BAR; }
        E(acc, cur, wr, wc, fr, fq);
        if (!has_next) break;
#pragma unroll
        for (int a = 0; a < 2; ++a)
#pragma unroll
            for (int b = 0; b < 2; ++b)
#pragma unroll
                for (int m = 0; m < 4; ++m)
#pragma unroll
                    for (int n = 0; n < 2; ++n) acc[a][b][m][n] = (f32x4){0.f, 0.f, 0.f, 0.f};
        cur = nxt; cA = nA; cB = nB; ++ui;
        if constexpr (ALIGN_EPI) { if (wr == 1) PG8_BAR; }
    }
    PG8_WAIT_V(0);
    if constexpr (!ALIGN_EPI) { if (wr == 0) PG8_BAR; }
    PG8_BAR;
#undef PG8_SA
#undef PG8_SB
#undef PG8_STAGE
#undef PG8_LDA
#undef PG8_LDB
#undef PG8_MMA
#undef PG8_WAIT_V
#undef PG8_WAIT_L
#undef PG8_BAR
#undef PG8_SCHED
}
}

constexpr int NWAVES = 8;
constexpr int DM = 1024, NBP = 16, TP = 2048, NBS = 16, TS = 64;
constexpr int MP = NBP * TP, MS = NBS * TS, M = MP + MS;
constexpr int LDZ = 5184;
constexpr int ZU = 0, ZQ = 1024, ZK = 1536, ZV = 2048, ZGP = 3072, ZGG = 4096, ZLR = 5120;
constexpr int NIN = 5136, NINP = 5376;
constexpr int NM = M / 256;
constexpr float EPS = 1e-6f;
constexpr size_t O_Y = 0, O_NPP = (size_t)M * DM, O_NGP = O_NPP + 16 * 15 * 1024, O_NPS = O_NGP + 16 * 4 * 128 * 256, O_NGS = O_NPS + 16 * 15 * 1024, O_END = O_NGS + 16 * 4 * 128 * 256;

constexpr size_t MiB = 1u << 20;
constexpr size_t WS_CTL = 0, CTL_ZERO_BYTES = 1 * MiB;
constexpr size_t WS_WIN = 2 * MiB;
constexpr size_t WS_WOUT = 13 * MiB;
constexpr size_t WS_WP = 17 * MiB;
constexpr size_t WS_PART = 18 * MiB;
constexpr size_t WS_XN = 24 * MiB;
constexpr size_t WS_Z = 96 * MiB;
constexpr size_t WS_END = WS_Z + (size_t)M * LDZ * 2;
static_assert(WS_WIN + (size_t)NINP * 1024 * 2 <= WS_WOUT && WS_PART + (size_t)M * 64 <= WS_XN && WS_XN + (size_t)M * 2048 <= WS_Z, "ws map");
constexpr int CW_BAR = 4096;

constexpr int RING_BYTES = 131072;
constexpr int LDSCTL_OFF = RING_BYTES, MISC_OFF = LDSCTL_OFF + 320;
constexpr int LDS_BYTES = 147456;

#define GAS __attribute__((address_space(1)))
#define LAS __attribute__((address_space(3)))
typedef unsigned short bf16;
typedef unsigned v4u __attribute__((ext_vector_type(4)));
typedef unsigned v2u __attribute__((ext_vector_type(2)));
typedef float f32x4 __attribute__((ext_vector_type(4)));
typedef float f32x16 __attribute__((ext_vector_type(16)));
typedef short bf16x8 __attribute__((ext_vector_type(8)));
typedef GAS unsigned gu32;
#define RLX_AGENT __ATOMIC_RELAXED, __HIP_MEMORY_SCOPE_AGENT
#define LDS_WAIT() asm volatile("s_waitcnt lgkmcnt(0)" ::: "memory")
__device__ __forceinline__ unsigned f2bf(float f) { unsigned u = __builtin_bit_cast(unsigned, f); return (u + 0x7fffu + ((u >> 16) & 1u)) >> 16; }
__device__ __forceinline__ unsigned pk2(float lo, float hi) { return f2bf(lo) | (f2bf(hi) << 16); }
__device__ __forceinline__ float bf2f(unsigned u16) { return __builtin_bit_cast(float, u16 << 16); }
__device__ __forceinline__ float bflo(unsigned w) { return __builtin_bit_cast(float, w << 16); }
__device__ __forceinline__ float bfhi(unsigned w) { return __builtin_bit_cast(float, w & 0xffff0000u); }
__device__ __forceinline__ float silu_f(float x) { return x * __builtin_amdgcn_rcpf(1.0f + __expf(-x)); }

#define XB_TMO      128
#define XB_XCNT(j)  (256  + 64 * (j))
#define XB_XSUB(j)  (1280 + 64 * (j))
#define XB_XGEN(j)  (2304 + 64 * (j))
#define XB_TOP      3328
#define XB_TOPGEN   3392
#define XCD_BAR_WORDS 3456
#define XB_SPIN_CAP (1u << 18)
__device__ __forceinline__ unsigned xb_ld(unsigned* p)              { return __hip_atomic_load(p, __ATOMIC_RELAXED, __HIP_MEMORY_SCOPE_AGENT); }
__device__ __forceinline__ unsigned xb_add(unsigned* p, unsigned v) { return __hip_atomic_fetch_add(p, v, __ATOMIC_RELAXED, __HIP_MEMORY_SCOPE_AGENT); }
__device__ __forceinline__ unsigned xb_xcc_id() { return (unsigned)__builtin_amdgcn_s_getreg((3 << 11) | 20) & 0xFu; }
#define XB_SPIN(cond, bar) do { unsigned _sp = 0; while (cond) { __builtin_amdgcn_s_sleep(1); \
    if ((++_sp & 255u) == 0u) { if (xb_ld(&(bar)[XB_TMO])) break; if (_sp > XB_SPIN_CAP) { atomicAdd(&(bar)[XB_TMO], 1u); break; } } } } while (0)
struct XcdBarrier { unsigned* bar; unsigned x; volatile LAS unsigned* st; };
__device__ __forceinline__ XcdBarrier xcd_barrier_post(unsigned* bar, volatile LAS unsigned* st) {
    XcdBarrier b; b.bar = bar; b.x = xb_xcc_id(); b.st = st;
    if (threadIdx.x == 0) (void)xb_add(&bar[XB_XCNT(b.x)], 1u);
    return b;
}
__device__ __forceinline__ void xcd_barrier_complete(unsigned* bar, unsigned x, unsigned& nloc, unsigned& nx) {
    const unsigned G = gridDim.x * gridDim.y * gridDim.z;
    unsigned sum, cnt, mine, sp = 0u;
    for (;;) {
        sum = 0u; cnt = 0u; mine = 0u;
#pragma unroll
        for (unsigned j = 0; j < 16; ++j) { const unsigned c = xb_ld(&bar[XB_XCNT(j)]); sum += c; cnt += (c > 0u) ? 1u : 0u; mine = (j == x) ? c : mine; }
        if (sum == G) break;
        __builtin_amdgcn_s_sleep(1);
        if ((++sp & 255u) == 0u) { if (xb_ld(&bar[XB_TMO])) break; if (sp > XB_SPIN_CAP) { atomicAdd(&bar[XB_TMO], 1u); break; } }
    }
    nloc = mine > 0u ? mine : 1u; nx = cnt > 0u ? cnt : 1u;
}
__device__ __forceinline__ void xcd_barrier(const XcdBarrier& b) {
    asm volatile("s_waitcnt vmcnt(0)" ::: "memory");
    __syncthreads();
    if (threadIdx.x == 0) {
        unsigned* bar = b.bar;
        __builtin_amdgcn_s_waitcnt(0);
        unsigned nloc = b.st[0], nx = b.st[1];
        if (nloc == 0u) { xcd_barrier_complete(bar, b.x, nloc, nx); b.st[0] = nloc; b.st[1] = nx; }
        const unsigned old = xb_add(&bar[XB_XSUB(b.x)], 1u);
        const unsigned gen = old / nloc;
        if (old + 1u == (gen + 1u) * nloc) {
            __builtin_amdgcn_fence(__ATOMIC_RELEASE, "agent");
            asm volatile("s_waitcnt vmcnt(0)" ::: "memory");
            const unsigned og = xb_add(&bar[XB_TOP], 1u);
            const unsigned tg = og / nx;
            if (og + 1u == (tg + 1u) * nx) xb_add(&bar[XB_TOPGEN], 1u);
            else XB_SPIN(xb_ld(&bar[XB_TOPGEN]) == tg, bar);
            __builtin_amdgcn_fence(__ATOMIC_ACQUIRE, "agent");
            xb_add(&bar[XB_XGEN(b.x)], 1u);
            asm volatile("s_waitcnt vmcnt(0)" ::: "memory");
        } else {
            XB_SPIN(xb_ld(&bar[XB_XGEN(b.x)]) == gen, bar);
            __builtin_amdgcn_fence(__ATOMIC_ACQUIRE, "agent");
            asm volatile("s_waitcnt vmcnt(0)" ::: "memory");
        }
    }
    __syncthreads();
}

struct EpiZ {
    static constexpr bool PERM = true;
    bf16* Z;
    __device__ __forceinline__ void operator()(const f32x4 (&acc)[2][2][4][2], const pg8::Unit& u, int wr, int wc, int fr, int fq) const {
        const int row0 = u.pm * 256 + wr * 64 + fr, col0 = u.pn * 256 + wc * 32 + 8 * fq;
        const int pn = u.pn; const bool dosilu = (pn >= 12 && pn < 20), lr = (pn == 20);
        const float sc = (pn == 4 || pn == 5) ? 0.08838834764831845f : 1.0f;
#pragma unroll
        for (int ai = 0; ai < 2; ++ai)
#pragma unroll
            for (int m = 0; m < 4; ++m) { bf16* rowp = Z + (size_t)(row0 + ai * 128 + m * 16) * LDZ + col0;
#pragma unroll
                for (int bj = 0; bj < 2; ++bj) { f32x4 v0 = acc[ai][bj][m][0], v1 = acc[ai][bj][m][1];
                    if (dosilu) { v0 = (f32x4){silu_f(v0[0]), silu_f(v0[1]), silu_f(v0[2]), silu_f(v0[3])}; v1 = (f32x4){silu_f(v1[0]), silu_f(v1[1]), silu_f(v1[2]), silu_f(v1[3])}; }
                    v0 = v0 * sc; v1 = v1 * sc;
                    v4u w; w.x = pg8::cvt_pk_bf16(v0[0], v0[1]); w.y = pg8::cvt_pk_bf16(v0[2], v0[3]); w.z = pg8::cvt_pk_bf16(v1[0], v1[1]); w.w = pg8::cvt_pk_bf16(v1[2], v1[3]);
                    if (!lr || (bj == 0 && wc == 0 && fq < 2)) *(v4u*)(rowp + bj * 128) = w; } }
    }
};
struct EpiPool {
    static constexpr bool PERM = true;
    bf16* Z; const float* scale;
    __device__ __forceinline__ void operator()(const f32x4 (&acc)[2][2][4][2], const pg8::Unit& u, int wr, int wc, int fr, int fq) const {
        const int row0 = u.pm * 256 + wr * 64 + fr, col0 = u.pn * 256 + wc * 32 + 8 * fq;
        f32x4 sv[2][2];
#pragma unroll
        for (int bj = 0; bj < 2; ++bj)
#pragma unroll
            for (int n = 0; n < 2; ++n) sv[bj][n] = *(const f32x4*)(scale + col0 + bj * 128 + 4 * n);
#pragma unroll
        for (int ai = 0; ai < 2; ++ai)
#pragma unroll
            for (int m = 0; m < 4; ++m) { bf16* rowp = Z + (size_t)(row0 + ai * 128 + m * 16) * LDZ + ZGP + col0;
#pragma unroll
                for (int bj = 0; bj < 2; ++bj) { const v4u gsg = *(const v4u*)(rowp + bj * 128);
                    f32x4 v0 = acc[ai][bj][m][0] * sv[bj][0], v1 = acc[ai][bj][m][1] * sv[bj][1];
                    v0 = v0 * (f32x4){bflo(gsg.x), bfhi(gsg.x), bflo(gsg.y), bfhi(gsg.y)}; v1 = v1 * (f32x4){bflo(gsg.z), bfhi(gsg.z), bflo(gsg.w), bfhi(gsg.w)};
                    v4u w; w.x = pg8::cvt_pk_bf16(v0[0], v0[1]); w.y = pg8::cvt_pk_bf16(v0[2], v0[3]); w.z = pg8::cvt_pk_bf16(v1[0], v1[1]); w.w = pg8::cvt_pk_bf16(v1[2], v1[3]);
                    *(v4u*)(rowp + bj * 128) = w; } }
    }
};
struct EpiRaw {
    static constexpr bool PERM = false;
    float* out; float* part;
    __device__ __forceinline__ void operator()(const f32x4 (&acc)[2][2][4][2], const pg8::Unit& u, int wr, int wc, int fr, int fq) const {
        const int col0 = u.pn * 256 + wc * 32 + 4 * fq;
#pragma unroll
        for (int ai = 0; ai < 2; ++ai)
#pragma unroll
            for (int m = 0; m < 4; ++m) { const int row = u.pm * 256 + ai * 128 + wr * 64 + m * 16 + fr; float* rowp = out + (size_t)row * DM + col0; float s = 0.f;
#pragma unroll
                for (int bj = 0; bj < 2; ++bj)
#pragma unroll
                    for (int n = 0; n < 2; ++n) { const f32x4 x = acc[ai][bj][m][n]; *(f32x4*)(rowp + bj * 128 + n * 16) = x; s += (x[0] * x[0] + x[1] * x[1]) + (x[2] * x[2] + x[3] * x[3]); }
                s += __shfl_xor(s, 16); s += __shfl_xor(s, 32);
                if (fq == 0) part[(size_t)row * 16 + u.pn * 4 + wc] = s; }
    }
};

struct Args { const float* in[13]; float* out; unsigned char* ws; int ph_lo, ph_hi; };
struct Frame {
    LAS unsigned char* lds;
    int tid, lane, wave, G;
};
#define A_XP(a) ((a).in[0])
#define A_XS(a) ((a).in[1])
#define A_SPOOL(a) ((a).in[2])
#define A_SGLA(a) ((a).in[3])
#define A_GPRE(a) ((a).in[4])
#define A_WIN(a) ((a).in[5])
#define A_WGU(a) ((a).in[6])
#define A_BGU(a) ((a).in[7])
#define A_WPOOL(a) ((a).in[8])
#define A_PSCALE(a) ((a).in[9])
#define A_GGO(a) ((a).in[10])
#define A_WOUT(a) ((a).in[11])
#define A_GPOST(a) ((a).in[12])
#define A_WINT(a) ((bf16*)((a).ws + WS_WIN))
#define A_WOUTT(a) ((bf16*)((a).ws + WS_WOUT))
#define A_WPT(a) ((bf16*)((a).ws + WS_WP))
#define A_XN(a) ((bf16*)((a).ws + WS_XN))
#define A_Z(a) ((bf16*)((a).ws + WS_Z))
#define A_PART(a) ((float*)((a).ws + WS_PART))
__device__ __forceinline__ float wave_sum(float v) {
#pragma unroll
    for (int o = 1; o < 64; o <<= 1) v += __shfl_xor(v, o);
    return v;
}
__device__ __forceinline__ const float* xrow(const Args& A, int m) { return m < MP ? A_XP(A) + (size_t)m * DM : A_XS(A) + (size_t)(m - MP) * DM; }

__device__ __forceinline__ void p0_transpose_item(const float* W, int K, int N, bf16* WT, int dstrow0, int nsrc0, int nvalid, int k0, LAS float* scr, int lane) {
#pragma unroll 8
    for (int i = 0; i < 32; ++i) { const int kk = 2 * i + (lane >> 5); const int n = lane & 31; scr[kk * 33 + n] = (n < nvalid) ? W[(size_t)(k0 + kk) * N + nsrc0 + n] : 0.f; }
    LDS_WAIT(); asm volatile("" ::: "memory");
    const int c = lane & 7;
#pragma unroll
    for (int j = 0; j < 4; ++j) { const int n = (lane >> 3) + 8 * j; const LAS float* s = scr + (8 * c) * 33 + n;
        v4u o; o.x = pk2(s[0 * 33], s[1 * 33]); o.y = pk2(s[2 * 33], s[3 * 33]); o.z = pk2(s[4 * 33], s[5 * 33]); o.w = pk2(s[6 * 33], s[7 * 33]);
        *(GAS v4u*)(WT + (size_t)(dstrow0 + n) * K + k0 + 8 * c) = o; }
    LDS_WAIT(); asm volatile("" ::: "memory");
}
__device__ __forceinline__ void p0_prologue(Frame& F, const Args& A) {
    LAS float* scr = (LAS float*)(F.lds + F.wave * 16384);
    const int gw = blockIdx.x * NWAVES + F.wave, NGW = F.G * NWAVES;
    constexpr int I_IN = (1024 / 64) * (NINP / 32), I_OUT = (2048 / 64) * (1024 / 32), I_P = 4 * (256 / 64) * (256 / 32);
    for (int it = gw; it < I_IN + I_OUT + I_P; it += NGW) {
        int r = it;
        if (r < I_IN) { const int nblk = NINP / 32, kb = r / nblk, nb = r % nblk, n0 = 32 * nb;
            int src = n0, nvalid = 32;
            if (n0 >= 1024 && n0 < 3072) src = n0 + 1024; else if (n0 >= 3072 && n0 < 4096) src = n0 - 2048;
            if (n0 == 5120) nvalid = 16; else if (n0 > 5120) { nvalid = 0; src = 0; }
            p0_transpose_item(A_WIN(A), 1024, NIN, A_WINT(A), n0, src, nvalid, 64 * kb, scr, F.lane); continue; }
        r -= I_IN;
        if (r < I_OUT) { const int nblk = 1024 / 32, kb = r / nblk, nb = r % nblk; p0_transpose_item(A_WOUT(A), 2048, 1024, A_WOUTT(A), 32 * nb, 32 * nb, 32, 64 * kb, scr, F.lane); continue; }
        r -= I_OUT;
        { const int gq = r / 32, rr = r % 32, kb = rr / 8, nb = rr % 8; p0_transpose_item(A_WPOOL(A) + (size_t)gq * 65536, 256, 256, A_WPT(A), gq * 256 + 32 * nb, 32 * nb, 32, 64 * kb, scr, F.lane); }
    }
    f32x4 gp[4];
#pragma unroll
    for (int j = 0; j < 4; ++j) gp[j] = *((const f32x4*)A_GPRE(A) + F.lane + 64 * j);
    for (int m = gw; m < M; m += NGW) {
        const GAS f32x4* xr = (const GAS f32x4*)xrow(A, m) + F.lane;
        f32x4 v[4]; float s2 = 0.f;
#pragma unroll
        for (int j = 0; j < 4; ++j) { v[j] = xr[64 * j]; s2 += (v[j].x * v[j].x + v[j].y * v[j].y) + (v[j].z * v[j].z + v[j].w * v[j].w); }
        const float rinv = 1.0f / sqrtf(wave_sum(s2) * (1.f / DM) + EPS);
        GAS unsigned long long* o8 = (GAS unsigned long long*)(A_XN(A) + (size_t)m * DM) + F.lane;
#pragma unroll
        for (int j = 0; j < 4; ++j) o8[64 * j] = (unsigned long long)pk2(v[j].x * rinv * gp[j].x, v[j].y * rinv * gp[j].y) | ((unsigned long long)pk2(v[j].z * rinv * gp[j].z, v[j].w * rinv * gp[j].w) << 32);
    }
}

__device__ __forceinline__ void ld_u8(const Args& A, int seqbase, int tau, bool samp, int b, int c0, float (&o)[8]) {
    if (tau >= 0) { const v4u w = *(const v4u*)(A_Z(A) + (size_t)(seqbase + tau) * LDZ + ZU + c0);
        o[0] = bflo(w.x); o[1] = bfhi(w.x); o[2] = bflo(w.y); o[3] = bfhi(w.y); o[4] = bflo(w.z); o[5] = bfhi(w.z); o[6] = bflo(w.w); o[7] = bfhi(w.w); }
    else if (samp) { const float* sp = A_SPOOL(A) + ((size_t)b * 15 + (15 + tau)) * 1024 + c0; const f32x4 a = *(const f32x4*)sp, bb = *(const f32x4*)(sp + 4);
        o[0] = a.x; o[1] = a.y; o[2] = a.z; o[3] = a.w; o[4] = bb.x; o[5] = bb.y; o[6] = bb.z; o[7] = bb.w; }
    else {
#pragma unroll
        for (int e = 0; e < 8; ++e) o[e] = 0.f; }
}
__device__ __forceinline__ void p2_poolgen(Frame& F, const Args& A) {
    const int cgp = F.tid & 127, rq = F.tid >> 7, w = 2 << (cgp >> 5), c0 = cgp * 8;
    for (int it = blockIdx.x; it < M / 64; it += F.G) {
        const int row0 = it * 64; const bool samp = row0 >= MP;
        int b, t0; if (!samp) { b = row0 / TP; t0 = row0 % TP; } else { b = (row0 - MP) / TS; t0 = 0; }
        const int seqbase = row0 - t0, ts = t0 + rq * 16;
        float sum[8], cur[8];
#pragma unroll
        for (int e = 0; e < 8; ++e) sum[e] = 0.f;
        for (int j = 1; j < 16; ++j) if (j < w) { ld_u8(A, seqbase, ts - j, samp, b, c0, cur);
#pragma unroll
            for (int e = 0; e < 8; ++e) sum[e] += cur[e]; }
        for (int jj = 0; jj < 16; ++jj) { const int t = ts + jj;
            ld_u8(A, seqbase, t, samp, b, c0, cur);
            const int cnt = samp ? w : (t + 1 < w ? t + 1 : w); const float rc = 1.0f / (float)cnt;
            float p[8];
#pragma unroll
            for (int e = 0; e < 8; ++e) { sum[e] += cur[e]; p[e] = sum[e] * rc - cur[e]; }
            v4u o; o.x = pk2(p[0], p[1]); o.y = pk2(p[2], p[3]); o.z = pk2(p[4], p[5]); o.w = pk2(p[6], p[7]);
            *(v4u*)(A_XN(A) + (size_t)(seqbase + t) * DM + c0) = o;
            ld_u8(A, seqbase, t - w + 1, samp, b, c0, cur);
#pragma unroll
            for (int e = 0; e < 8; ++e) sum[e] -= cur[e]; }
    }
    const int gw = blockIdx.x * NWAVES + F.wave, NGW = F.G * NWAVES;
    for (int r = gw; r < 32 * 15; r += NGW) { const int s = r / 15, i = r % 15;
        const int src = s < 16 ? s * TP + (TP - 15) + i : MP + (s - 16) * TS + (TS - 15) + i;
        float* dst = A.out + (s < 16 ? O_NPP + (size_t)(s * 15 + i) * 1024 : O_NPS + (size_t)((s - 16) * 15 + i) * 1024);
        const bf16* sp = A_Z(A) + (size_t)src * LDZ + ZU;
#pragma unroll
        for (int j = 0; j < 2; ++j) { const int c = 8 * F.lane + 512 * j; const v4u w4 = *(const v4u*)(sp + c);
            *(f32x4*)(dst + c) = (f32x4){bflo(w4.x), bfhi(w4.x), bflo(w4.y), bfhi(w4.y)}; *(f32x4*)(dst + c + 4) = (f32x4){bflo(w4.z), bfhi(w4.z), bflo(w4.w), bfhi(w4.w)}; }
    }
}

constexpr int GL_GLR = 0, GL_GTOT = 4096, GL_DEXP = 6144, GL_PART = 6656, GL_QT = 8704, GL_KT = 26112, GL_VT = 43520, GL_VR = 80384, GL_KDT = GL_VR, GL_PP = GL_VR + 18432, GL_WG = GL_VR + 33792, GL_GG = GL_WG + 8704, GL_END = GL_GG + 1024;
static_assert(GL_END <= 131072 && GL_PP + 9216 <= GL_WG, "GLA LDS map");
#define OPQ(x) asm volatile("" : "+v"(x))
__device__ __forceinline__ void gla_unit(Frame& F, const Args& A, int row0, int nchunk, int h, const float* S0, float* Sout) {
    LAS unsigned char* lds = F.lds;
    LAS float* GLR = (LAS float*)(lds + GL_GLR); LAS float* GTOT = (LAS float*)(lds + GL_GTOT); LAS float* DEXP = (LAS float*)(lds + GL_DEXP); LAS float* PART = (LAS float*)(lds + GL_PART);
    LAS unsigned char* QT = lds + GL_QT; LAS unsigned char* KT = lds + GL_KT; LAS unsigned char* KDT = lds + GL_KDT; LAS unsigned char* VT = lds + GL_VT; LAS unsigned char* PP = lds + GL_PP; LAS unsigned char* VR = lds + GL_VR;
    LAS float* WG = (LAS float*)(lds + GL_WG); LAS float* GG = (LAS float*)(lds + GL_GG);
    const int wid = F.wave;
    const bf16* Z = A_Z(A);
    { const int tid = F.tid;
#pragma unroll
      for (int i = 0; i < 4; ++i) { const int idx = tid + 512 * i, r = idx >> 7, k = idx & 127; WG[idx] = A_WGU(A)[r * 512 + h * 128 + k]; }
      if (tid < 128) WG[2048 + tid] = A_BGU(A)[h * 128 + tid];
      if (tid < 256) GG[tid] = A_GGO(A)[tid]; }
    f32x16 S[4];
    { const int hh = F.lane >> 5, l31 = F.lane & 31;
      if (S0) {
#pragma unroll
        for (int kb = 0; kb < 4; ++kb)
#pragma unroll
            for (int r = 0; r < 16; ++r) { const int k = 32 * kb + (r & 3) + 8 * (r >> 2) + 4 * hh; S[kb][r] = S0[(size_t)k * 256 + 32 * wid + l31]; }
      } else {
#pragma unroll
        for (int kb = 0; kb < 4; ++kb)
#pragma unroll
            for (int r = 0; r < 16; ++r) S[kb][r] = 0.f;
      } }
    __syncthreads();

    for (int c = 0; c < nchunk; ++c) {
        const char* zc = (const char*)Z + (size_t)(row0 + 64 * c) * (LDZ * 2);
        { int tid = F.tid; OPQ(tid);
          { const int row = tid >> 3, cc = 2 * (tid & 7);
            const unsigned w2 = *(const unsigned*)(zc + (unsigned)((row * LDZ + ZLR + cc) * 2));
            GLR[row * 16 + cc] = bflo(w2); GLR[row * 16 + cc + 1] = bfhi(w2); }
          v4u rq[2], rk[2], rv[4];
#pragma unroll
          for (int i = 0; i < 2; ++i) { const int idx = tid + 512 * i, row = idx >> 4, c8 = idx & 15; const unsigned off = (unsigned)((row * LDZ + ZQ + h * 128 + 8 * c8) * 2); rq[i] = *(const v4u*)(zc + off); rk[i] = *(const v4u*)(zc + off + (ZK - ZQ) * 2); }
#pragma unroll
          for (int i = 0; i < 4; ++i) { const int idx = tid + 512 * i, row = idx >> 5, c8 = idx & 31; const unsigned off = (unsigned)((row * LDZ + ZV + h * 256 + 8 * c8) * 2); rv[i] = *(const v4u*)(zc + off); }
#pragma unroll
          for (int i = 0; i < 2; ++i) { const int idx = tid + 512 * i, row = idx >> 4, c8 = idx & 15; *(LAS v4u*)(QT + (row * 136 + 8 * c8) * 2) = rq[i]; *(LAS v4u*)(KT + (row * 136 + 8 * c8) * 2) = rk[i]; }
#pragma unroll
          for (int i = 0; i < 4; ++i) { const int idx = tid + 512 * i, row = idx >> 5, c8 = idx & 31; *(LAS v4u*)(VR + (row * 264 + 8 * c8) * 2) = rv[i]; } }
        __syncthreads();
        { int tid = F.tid; OPQ(tid); const int vv = tid & 255, jh = tid >> 8;
#pragma unroll
          for (int q = 0; q < 4; ++q) { unsigned e[8];
#pragma unroll
              for (int x = 0; x < 8; ++x) e[x] = *(const LAS unsigned short*)(VR + ((32 * jh + 8 * q + x) * 264 + vv) * 2);
              *(LAS v4u*)(VT + (vv * 72 + 32 * jh + 8 * q) * 2) = (v4u){e[0] | (e[1] << 16), e[2] | (e[3] << 16), e[4] | (e[5] << 16), e[6] | (e[7] << 16)}; } }
        float bcum[16]; float run = 0.f;
        { int tid = F.tid; OPQ(tid); const int kcol = tid & 127, jg = tid >> 7;
          float wg[16];
#pragma unroll
          for (int r = 0; r < 16; ++r) wg[r] = WG[r * 128 + kcol];
          const float bias = WG[2048 + kcol];
#pragma unroll
          for (int jj = 0; jj < 16; ++jj) { float a = bias; const LAS f32x4* gr = (const LAS f32x4*)(GLR + (16 * jg + jj) * 16);
#pragma unroll
            for (int q = 0; q < 4; ++q) { const f32x4 g4 = gr[q]; a += g4.x * wg[4 * q] + g4.y * wg[4 * q + 1] + g4.z * wg[4 * q + 2] + g4.w * wg[4 * q + 3]; }
            const float la = (fminf(a, 0.f) - __logf(1.0f + __expf(-fabsf(a)))) * (1.0f / 16.0f);
            run += la; bcum[jj] = run; }
          GTOT[jg * 128 + kcol] = run; }
        __syncthreads();
        { int tid = F.tid; OPQ(tid); const int kcol = tid & 127, jg = tid >> 7;
          float off = 0.f, bend = 0.f;
#pragma unroll
          for (int g = 0; g < 4; ++g) { const float t = GTOT[g * 128 + kcol]; if (g < jg) off += t; bend += t; }
          unsigned kdp[8];
#pragma unroll
          for (int jj = 0; jj < 16; ++jj) { const float b = bcum[jj] + off;
            LAS unsigned short* qp = (LAS unsigned short*)(QT + ((16 * jg + jj) * 136 + kcol) * 2); LAS unsigned short* kp = (LAS unsigned short*)(KT + ((16 * jg + jj) * 136 + kcol) * 2);
            const float q = bf2f(*qp), k = bf2f(*kp);
            const float qt = q * __expf(b), kt = k * __expf(-b), kd = k * __expf(bend - b);
            *qp = (unsigned short)f2bf(qt); *kp = (unsigned short)f2bf(kt);
            if (jj & 1) kdp[jj >> 1] |= f2bf(kd) << 16; else kdp[jj >> 1] = f2bf(kd); }
          *(LAS v4u*)(KDT + (kcol * 72 + 16 * jg) * 2) = (v4u){kdp[0], kdp[1], kdp[2], kdp[3]};
          *(LAS v4u*)(KDT + (kcol * 72 + 16 * jg + 8) * 2) = (v4u){kdp[4], kdp[5], kdp[6], kdp[7]};
          if (jg == 0) DEXP[kcol] = __expf(bend); }
        __syncthreads();
        if (wid < 3) { int lane = F.lane; OPQ(lane); const int hh = lane >> 5, l31 = lane & 31;
            const int jb = (wid == 2) ? 1 : 0, ib = (wid >= 1) ? 1 : 0;
            f32x16 sc;
#pragma unroll
            for (int r = 0; r < 16; ++r) sc[r] = 0.f;
#pragma unroll
            for (int s = 0; s < 8; ++s) { const bf16x8 a = *(const LAS bf16x8*)(KT + ((32 * jb + l31) * 136 + 16 * s + 8 * hh) * 2); const bf16x8 bq = *(const LAS bf16x8*)(QT + ((32 * ib + l31) * 136 + 16 * s + 8 * hh) * 2);
                sc = __builtin_amdgcn_mfma_f32_32x32x16_bf16(a, bq, sc, 0, 0, 0); }
            const int i = 32 * ib + l31;
#pragma unroll
            for (int g = 0; g < 4; ++g) { const int j0 = 32 * jb + 8 * g + 4 * hh; float v[4];
#pragma unroll
                for (int e = 0; e < 4; ++e) v[e] = (i >= j0 + e) ? sc[4 * g + e] : 0.f;
                *(LAS v2u*)(PP + (i * 72 + j0) * 2) = (v2u){pk2(v[0], v[1]), pk2(v[2], v[3])}; } }
        __syncthreads();
        f32x16 o[2];
        { int lane = F.lane; OPQ(lane); const int hh = lane >> 5, l31 = lane & 31;
#pragma unroll
          for (int ib = 0; ib < 2; ++ib)
#pragma unroll
            for (int r = 0; r < 16; ++r) o[ib][r] = 0.f;
#pragma unroll
          for (int s = 0; s < 4; ++s) { const bf16x8 a = *(const LAS bf16x8*)(VT + ((32 * wid + l31) * 72 + 16 * s + 8 * hh) * 2);
            if (s < 2) { const bf16x8 b0 = *(const LAS bf16x8*)(PP + (l31 * 72 + 16 * s + 8 * hh) * 2); o[0] = __builtin_amdgcn_mfma_f32_32x32x16_bf16(a, b0, o[0], 0, 0, 0); }
            const bf16x8 b1 = *(const LAS bf16x8*)(PP + ((32 + l31) * 72 + 16 * s + 8 * hh) * 2); o[1] = __builtin_amdgcn_mfma_f32_32x32x16_bf16(a, b1, o[1], 0, 0, 0); }
#pragma unroll
          for (int kb = 0; kb < 4; ++kb)
#pragma unroll
            for (int s = 0; s < 2; ++s) {
                v4u af; af.x = pg8::cvt_pk_bf16(S[kb][8 * s + 0], S[kb][8 * s + 1]); af.y = pg8::cvt_pk_bf16(S[kb][8 * s + 2], S[kb][8 * s + 3]); af.z = pg8::cvt_pk_bf16(S[kb][8 * s + 4], S[kb][8 * s + 5]); af.w = pg8::cvt_pk_bf16(S[kb][8 * s + 6], S[kb][8 * s + 7]);
                const bf16x8 a = __builtin_bit_cast(bf16x8, af);
#pragma unroll
                for (int ib = 0; ib < 2; ++ib) { const LAS unsigned char* qp = QT + ((32 * ib + l31) * 136 + 32 * kb + 16 * s + 4 * hh) * 2;
                    const v2u lo = *(const LAS v2u*)qp, hi = *(const LAS v2u*)(qp + 16);
                    const bf16x8 bq = __builtin_bit_cast(bf16x8, ((v4u){lo.x, lo.y, hi.x, hi.y}));
                    o[ib] = __builtin_amdgcn_mfma_f32_32x32x16_bf16(a, bq, o[ib], 0, 0, 0); } }
#pragma unroll
          for (int ib = 0; ib < 2; ++ib) { float ss = 0.f;
#pragma unroll
            for (int r = 0; r < 16; ++r) ss += o[ib][r] * o[ib][r];
            ss += __shfl_xor(ss, 32);
            if (hh == 0) PART[wid * 64 + 32 * ib + l31] = ss; } }
        __syncthreads();
        { int lane = F.lane; OPQ(lane); const int hh = lane >> 5, l31 = lane & 31;
#pragma unroll
          for (int ib = 0; ib < 2; ++ib) { float tot = 0.f;
#pragma unroll
            for (int w8 = 0; w8 < 8; ++w8) tot += PART[w8 * 64 + 32 * ib + l31];
            const float rinv = 1.0f / sqrtf(tot * (1.0f / 256.0f) + EPS);
            char* yrow = (char*)zc + (unsigned)(((32 * ib + l31) * LDZ + ZGG + h * 256 + 32 * wid + 4 * hh) * 2);
#pragma unroll
            for (int g = 0; g < 4; ++g) { const v2u s2 = *(const v2u*)(yrow + 16 * g); const f32x4 g4 = *(const LAS f32x4*)(GG + 32 * wid + 8 * g + 4 * hh);
                const float y0 = o[ib][4 * g + 0] * rinv * g4.x * bflo(s2.x), y1 = o[ib][4 * g + 1] * rinv * g4.y * bfhi(s2.x);
                const float y2 = o[ib][4 * g + 2] * rinv * g4.z * bflo(s2.y), y3 = o[ib][4 * g + 3] * rinv * g4.w * bfhi(s2.y);
                *(v2u*)(yrow + 16 * g) = (v2u){pk2(y0, y1), pk2(y2, y3)}; } } }
        { int lane = F.lane; OPQ(lane); const int hh = lane >> 5, l31 = lane & 31;
#pragma unroll
          for (int kb = 0; kb < 4; ++kb) {
#pragma unroll
            for (int g = 0; g < 4; ++g) { const f32x4 d4 = *(const LAS f32x4*)(DEXP + 32 * kb + 8 * g + 4 * hh);
                S[kb][4 * g + 0] *= d4.x; S[kb][4 * g + 1] *= d4.y; S[kb][4 * g + 2] *= d4.z; S[kb][4 * g + 3] *= d4.w; }
#pragma unroll
            for (int s = 0; s < 4; ++s) { const bf16x8 a = *(const LAS bf16x8*)(KDT + ((32 * kb + l31) * 72 + 16 * s + 8 * hh) * 2); const bf16x8 bv = *(const LAS bf16x8*)(VT + ((32 * wid + l31) * 72 + 16 * s + 8 * hh) * 2);
                S[kb] = __builtin_amdgcn_mfma_f32_32x32x16_bf16(a, bv, S[kb], 0, 0, 0); } } }
        __syncthreads();
    }
    { const int hh = F.lane >> 5, l31 = F.lane & 31;
#pragma unroll
      for (int kb = 0; kb < 4; ++kb)
#pragma unroll
        for (int r = 0; r < 16; ++r) { const int k = 32 * kb + (r & 3) + 8 * (r >> 2) + 4 * hh; Sout[(size_t)k * 256 + 32 * wid + l31] = S[kb][r]; } }
    __syncthreads();
}

__device__ __forceinline__ void p5_finalize(Frame& F, const Args& A) {
    const int gw = blockIdx.x * NWAVES + F.wave, NGW = F.G * NWAVES;
    f32x4 gp[4];
#pragma unroll
    for (int j = 0; j < 4; ++j) gp[j] = *((const f32x4*)A_GPOST(A) + F.lane + 64 * j);
    for (int m = gw; m < M; m += NGW) {
        const float pv = (F.lane < 16) ? A_PART(A)[(size_t)m * 16 + F.lane] : 0.f;
        const float rinv = 1.0f / sqrtf(wave_sum(pv) * (1.f / DM) + EPS);
        const GAS f32x4* xr = (const GAS f32x4*)xrow(A, m) + F.lane; GAS f32x4* orow = (GAS f32x4*)(A.out + (size_t)m * DM) + F.lane;
#pragma unroll
        for (int j = 0; j < 4; ++j) { const f32x4 x = xr[64 * j], y = orow[64 * j]; orow[64 * j] = x + y * rinv * gp[j]; }
    }
}

__global__ void __launch_bounds__(NWAVES * 64, 2) mk_fwd(Args A) {
    extern __shared__ __attribute__((aligned(16))) unsigned char lds[];
    Frame F;
    F.lds = (LAS unsigned char*)lds;
    F.tid = threadIdx.x; F.lane = F.tid & 63; F.wave = __builtin_amdgcn_readfirstlane(F.tid >> 6); F.G = gridDim.x;
    const int lo = A.ph_lo, hi = A.ph_hi;
#ifndef PHASE_MASK
#define PHASE_MASK 63
#endif
#define IN(k) (((PHASE_MASK >> (k)) & 1) && lo <= (k) && (k) < hi)
#define BOTH(k) (IN(k) && IN((k) + 1))
#if MK_N_LAUNCHES == 1
    cg::grid_group grid = cg::this_grid();
#define GRID_BAR() grid.sync()
#else
#define GRID_BAR() do {} while (0)
#endif
    if (IN(0)) { p0_prologue(F, A); if (BOTH(0)) GRID_BAR(); }
    if (IN(1)) {
        pg8::Gemm g{A_XN(A), A_WINT(A), DM, DM, DM, 0}; pg8::StaticOrder S; S.init(NM, NINP / 256, F.G, (int)blockIdx.x);
        EpiZ E{A_Z(A)};
        pg8::gemm_phase<EpiZ, pg8::StaticOrder, true>(F.lds, g, S, E);
        if (BOTH(1)) GRID_BAR();
    }
    if (IN(2)) { p2_poolgen(F, A); if (BOTH(2)) GRID_BAR(); }
    if (IN(3)) {
        for (int u = blockIdx.x; u < 128; u += F.G) {
            const bool samp = u >= 64; const int us = samp ? u - 64 : u, b = us >> 2, h = us & 3;
            gla_unit(F, A, samp ? MP + b * TS : b * TP, samp ? 1 : TP / 64, h, samp ? A_SGLA(A) + (size_t)us * 32768 : nullptr, A.out + (samp ? O_NGS : O_NGP) + (size_t)us * 32768);
        }
        const int skip = F.G > 64 ? 64 : 0;
#ifndef NO_POOLGEMM
        if ((int)blockIdx.x >= skip) {
            pg8::Gemm g{A_XN(A), A_WPT(A), DM, 256, 256, 512}; pg8::StaticOrder S; S.init(NM, 4, F.G - skip, (int)blockIdx.x - skip);
            EpiPool E{A_Z(A), A_PSCALE(A)};
            pg8::gemm_phase<EpiPool, pg8::StaticOrder, true>(F.lds, g, S, E);
        }
#endif
        if (BOTH(3)) GRID_BAR();
    }
    if (IN(4)) {
        pg8::Gemm g{A_Z(A) + ZGP, A_WOUTT(A), LDZ, 2048, 2048, 0}; pg8::StaticOrder S; S.init(NM, 4, F.G, (int)blockIdx.x);
        EpiRaw E{A.out, A_PART(A)};
        pg8::gemm_phase<EpiRaw, pg8::StaticOrder, true>(F.lds, g, S, E);
        if (BOTH(4)) GRID_BAR();
    }
    if (IN(5)) { p5_finalize(F, A); }
#undef IN
#undef BOTH
}

extern "C" void kernel_launch(void* const* d_in, const int* in_sizes, int n_in, void* d_out, int out_size, void* d_ws, size_t ws_size, hipStream_t stream) {
    static int grid = 0;
    if (grid == 0) {
        if (n_in != 13 || in_sizes[0] != MP * DM || (size_t)out_size != O_END || ws_size < WS_END) {
            fprintf(stderr, "kernel_launch: unexpected shapes: n_in %d in0 %d out %d ws %zu (need %zu)\n", n_in, n_in > 0 ? in_sizes[0] : -1, out_size, ws_size, (size_t)WS_END); grid = -1; return; }
        int dev = 0, cus = 0, per_cu = 0;
        if (hipGetDevice(&dev) != hipSuccess || hipDeviceGetAttribute(&cus, hipDeviceAttributeMultiprocessorCount, dev) != hipSuccess) { grid = -1; return; }
        if (hipFuncSetAttribute((const void*)mk_fwd, hipFuncAttributeMaxDynamicSharedMemorySize, LDS_BYTES) != hipSuccess) { fprintf(stderr, "kernel_launch: hipFuncSetAttribute failed\n"); grid = -1; return; }
        if (hipOccupancyMaxActiveBlocksPerMultiprocessor(&per_cu, (const void*)mk_fwd, NWAVES * 64, LDS_BYTES) != hipSuccess || per_cu < 1) { fprintf(stderr, "kernel_launch: occupancy query failed (%d)\n", per_cu); (void)hipGetLastError(); grid = -1; return; }
        grid = cus;
    }
    if (grid < 0) return;
    (void)hipMemsetAsync((char*)d_ws + WS_CTL, 0, CTL_ZERO_BYTES, stream);
    Args a{};
    for (int i = 0; i < 13; ++i) a.in[i] = (const float*)d_in[i];
    a.out = (float*)d_out; a.ws = (unsigned char*)d_ws;
#if MK_N_LAUNCHES == 1
    a.ph_lo = 0; a.ph_hi = 6;
    void* kargs[] = {&a};
    hipError_t e = hipLaunchCooperativeKernel((const void*)mk_fwd, dim3(grid), dim3(NWAVES * 64), kargs, LDS_BYTES, stream);
    if (e != hipSuccess) fprintf(stderr, "cooperative launch failed: %s (grid %d)\n", hipGetErrorString(e), grid);
#else
    for (int li = 0; li < 6; ++li) { a.ph_lo = li; a.ph_hi = li + 1; hipLaunchKernelGGL(mk_fwd, dim3(grid), dim3(NWAVES * 64), LDS_BYTES, stream, a); }
#endif
}
```

```cpp
#include <hip/hip_runtime.h>
#include <hip/hip_cooperative_groups.h>
#include <cstdio>
#include <cstdint>
namespace cg = cooperative_groups;

#ifndef MK_N_LAUNCHES
#define MK_N_LAUNCHES 1
#endif

namespace pg8 {
#define PG8_LAS __attribute__((address_space(3)))
typedef unsigned short bf16_t;
typedef short bf16x8 __attribute__((ext_vector_type(8)));
typedef float f32x4 __attribute__((ext_vector_type(4)));
typedef unsigned u32x4 __attribute__((ext_vector_type(4)));
constexpr int BM = 256, BK = 64, HALF = 128, HTB = HALF * BK * 2  , STAGE_BYTES = 8 * HTB, NXCD = 8, WGM = 8;

__host__ __device__ __forceinline__ int lds_byte(int r, int c) { const int st = (r >> 4) * 2 + (c >> 5), rr = r & 15, cc = c & 31, ob = rr * 64 + cc * 2; return st * 1024 + (ob ^ (((ob >> 9) & 1) << 5)); }
__host__ __device__ __forceinline__ void stage_rc(int b, int& R, int& C) { const int st = b / 1024, sb = b % 1024, swz = sb ^ (((sb >> 9) & 1) << 5); R = (st >> 1) * 16 + swz / 64; C = (st & 1) * 32 + (swz % 64) / 2; }
__host__ __device__ __forceinline__ int perm32(int rho) { const int n = rho >> 4, i = rho & 15; return 8 * (i >> 2) + 4 * n + (i & 3); }

struct Unit { int pm, pn; };
struct Gemm { const bf16_t* A; const bf16_t* Bt; int lda, ldb, K, aShift; };

struct StaticOrder {
    int nM, nN, nwg, G, c;
    __host__ __device__ __forceinline__ void init(int nM_, int nN_, int G_, int c_) { nM = nM_; nN = nN_; nwg = nM * nN; G = G_; c = c_; }
    __host__ __device__ __forceinline__ bool next(int i, Unit& u) const {
        const long L = (long)i * G + c; if (L >= nwg) return false;
        int wgid = (int)L; { const int q = nwg / NXCD, r = nwg % NXCD, xcd = wgid % NXCD, off = wgid / NXCD; wgid = (xcd < r ? xcd * (q + 1) : r * (q + 1) + (xcd - r) * q) + off; }
        const int nig = WGM * nN, gid = wgid / nig, fm = gid * WGM, gsz = (nM - fm) < WGM ? (nM - fm) : WGM;
        u.pm = fm + ((wgid % nig) % gsz); u.pn = (wgid % nig) / gsz; return true;
    }
};

__device__ __forceinline__ unsigned cvt_pk_bf16(float lo, float hi) { unsigned r; asm volatile("v_cvt_pk_bf16_f32 %0, %1, %2" : "=v"(r) : "v"(lo), "v"(hi)); return r; }

template <class Epi, class Sched, bool ALIGN_EPI>
__device__ __forceinline__ void gemm_phase(PG8_LAS unsigned char* lds, const Gemm g, const Sched& S, const Epi& E) {
    int tid_ = threadIdx.x; asm volatile("" : "+v"(tid_));
    const int tid = tid_, wid = __builtin_amdgcn_readfirstlane(tid >> 6), lane = tid & 63, wr = wid >> 2, wc = wid & 3, fr = lane & 15, fq = lane >> 4;
    const int K = g.K, nt = K / BK;
    unsigned voffA[2], voffB[2];
#pragma unroll
    for (int i = 0; i < 2; ++i) { int R, C; stage_rc(tid * 16 + i * 8192, R, C); const int Rb = Epi::PERM ? ((R & ~31) + perm32(R & 31)) : R;
        voffA[i] = (unsigned)(R * g.lda + C) * 2u; voffB[i] = (unsigned)(Rb * g.ldb + C) * 2u; }
    const size_t kstep = (size_t)(BK * 2);
    const size_t hstepA = (size_t)HALF * g.lda * 2, hstepB = (size_t)HALF * g.ldb * 2;
    const size_t tstepA = 2 * hstepA, tstepB = 2 * hstepB;
    const unsigned ldsw = (unsigned)wid * 1024u;
    const int aoff = lds_byte(wr * 64 + fr, fq * 8), boff = lds_byte(wc * 32 + fr, fq * 8);
#define PG8_SA(b, h) (((b) * 2 + (h)) * HTB)
#define PG8_SB(b, h) ((4 + (b) * 2 + (h)) * HTB)
#define PG8_STAGE(bufoff, gbase, voff) do { _Pragma("unroll") for (int _i = 0; _i < 2; ++_i) \
        __builtin_amdgcn_global_load_lds((const unsigned*)((const char*)(gbase) + (voff)[_i]), (PG8_LAS unsigned*)(lds + (bufoff) + ldsw + _i * 8192), 16, 0, 0); } while (0)
#define PG8_LDA(dst, b, h) do { _Pragma("unroll") for (int m = 0; m < 4; ++m) _Pragma("unroll") for (int k = 0; k < 2; ++k) dst[m][k] = *(const PG8_LAS bf16x8*)(lds + PG8_SA(b, h) + aoff + m * 2048 + k * 1024); } while (0)
#define PG8_LDB(dst, b, h) do { _Pragma("unroll") for (int n = 0; n < 2; ++n) _Pragma("unroll") for (int k = 0; k < 2; ++k) dst[n][k] = *(const PG8_LAS bf16x8*)(lds + PG8_SB(b, h) + boff + n * 2048 + k * 1024); } while (0)
#define PG8_MMA(ai, bj, At, Bt) do { __builtin_amdgcn_s_setprio(1); _Pragma("unroll") for (int m = 0; m < 4; ++m) _Pragma("unroll") for (int n = 0; n < 2; ++n) _Pragma("unroll") for (int k = 0; k < 2; ++k) \
        acc[ai][bj][m][n] = __builtin_amdgcn_mfma_f32_16x16x32_bf16(Bt[n][k], At[m][k], acc[ai][bj][m][n], 0, 0, 0); __builtin_amdgcn_s_setprio(0); } while (0)
#define PG8_WAIT_V(n) asm volatile("s_waitcnt vmcnt(" #n ")" ::: "memory")
#define PG8_WAIT_L(n) asm volatile("s_waitcnt lgkmcnt(" #n ")" ::: "memory")
#define PG8_BAR __builtin_amdgcn_s_barrier()
#define PG8_SCHED __builtin_amdgcn_sched_barrier(0)
    Unit cur, nxt; int ui = 0;
    if (!S.next(0, cur)) return;
    f32x4 acc[2][2][4][2];
#pragma unroll
    for (int a = 0; a < 2; ++a)
#pragma unroll
        for (int b = 0; b < 2; ++b)
#pragma unroll
            for (int m = 0; m < 4; ++m)
#pragma unroll
                for (int n = 0; n < 2; ++n) acc[a][b][m][n] = (f32x4){0.f, 0.f, 0.f, 0.f};
    bf16x8 At[4][2], B0[2][2], B1[2][2];
    const char* cA = (const char*)g.A + (size_t)cur.pm * tstepA + (size_t)cur.pn * g.aShift; const char* cB = (const char*)g.Bt + (size_t)cur.pn * tstepB;
    PG8_STAGE(PG8_SB(0, 0), cB, voffB); PG8_STAGE(PG8_SB(0, 1), cB + hstepB, voffB); PG8_STAGE(PG8_SA(0, 0), cA, voffA); PG8_STAGE(PG8_SA(0, 1), cA + hstepA, voffA);
    if (wr == 1) PG8_BAR;
    PG8_WAIT_V(2); PG8_BAR;
    PG8_STAGE(PG8_SB(1, 0), cB + kstep, voffB); PG8_STAGE(PG8_SA(1, 0), cA + kstep, voffA); PG8_STAGE(PG8_SB(1, 1), cB + hstepB + kstep, voffB);
    PG8_WAIT_V(6); PG8_BAR;
    for (;;) {
        const bool has_next = S.next(ui + 1, nxt);
        const char* nA = has_next ? (const char*)g.A + (size_t)nxt.pm * tstepA + (size_t)nxt.pn * g.aShift : cA; const char* nB = has_next ? (const char*)g.Bt + (size_t)nxt.pn * tstepB : cB;
        for (int t = 0; t < nt; t += 2) {
            const bool last = (t == nt - 2);
            const char* a1 = cA + (size_t)(t + 1) * kstep;
            const char* a2 = last ? nA : cA + (size_t)(t + 2) * kstep; const char* b2 = last ? nB : cB + (size_t)(t + 2) * kstep;
            const char* a3 = a2 + kstep; const char* b3 = b2 + kstep;
            PG8_LDB(B0, 0, 0); PG8_LDB(B1, 0, 1); PG8_SCHED; PG8_LDA(At, 0, 0); PG8_STAGE(PG8_SA(1, 1), a1 + hstepA, voffA);
            PG8_WAIT_V(8); PG8_WAIT_L(0); PG8_BAR; PG8_MMA(0, 0, At, B0); PG8_MMA(0, 1, At, B1); PG8_BAR; PG8_SCHED;
            PG8_LDA(At, 0, 1); PG8_STAGE(PG8_SB(0, 0), b2, voffB); PG8_STAGE(PG8_SB(0, 1), b2 + hstepB, voffB); PG8_STAGE(PG8_SA(0, 0), a2, voffA);
            PG8_WAIT_V(8); PG8_WAIT_L(0); PG8_BAR; PG8_MMA(1, 0, At, B0); PG8_MMA(1, 1, At, B1); PG8_BAR; PG8_SCHED;
            PG8_LDB(B0, 1, 0); PG8_LDB(B1, 1, 1); PG8_SCHED; PG8_LDA(At, 1, 0); PG8_STAGE(PG8_SA(0, 1), a2 + hstepA, voffA);
            PG8_WAIT_V(8); PG8_WAIT_L(0); PG8_BAR; PG8_MMA(0, 0, At, B0); PG8_MMA(0, 1, At, B1); PG8_BAR; PG8_SCHED;
            PG8_LDA(At, 1, 1); PG8_STAGE(PG8_SB(1, 0), b3, voffB); PG8_STAGE(PG8_SB(1, 1), b3 + hstepB, voffB); PG8_STAGE(PG8_SA(1, 0), a3, voffA);
            PG8_WAIT_V(8); PG8_WAIT_L(0); PG8_BAR; PG8_MMA(1, 0, At, B0); PG8_MMA(1, 1, At, B1); PG8_BAR; PG8_SCHED;
        }
        if constexpr (ALIGN_EPI) { if (wr == 0) PG8_BAR; }
        E(acc, cur, wr, wc, fr, fq);
        if (!has_next) break;
#pragma unroll
        for (int a = 0; a < 2; ++a)
#pragma unroll
            for (int b = 0; b < 2; ++b)
#pragma unroll
                for (int m = 0; m < 4; ++m)
#pragma unroll
                    for (int n = 0; n < 2; ++n) acc[a][b][m][n] = (f32x4){0.f, 0.f, 0.f, 0.f};
        cur = nxt; cA = nA; cB = nB; ++ui;
        if constexpr (ALIGN_EPI) { if (wr == 1) PG8_BAR; }
    }
    PG8_WAIT_V(0);
    if constexpr (!ALIGN_EPI) { if (wr == 0) PG8_BAR; }
    PG8_BAR;
#undef PG8_SA
#undef PG8_SB
#undef PG8_STAGE
#undef PG8_LDA
#undef PG8_LDB
#undef PG8_MMA
#undef PG8_WAIT_V
#undef PG8_WAIT_L
#undef PG8_BAR
#undef PG8_SCHED
}
}

constexpr int NWAVES = 8;
constexpr int DM = 1024, NBP = 16, TP = 2048, NBS = 16, TS = 64;
constexpr int MP = NBP * TP, MS = NBS * TS, M = MP + MS;
constexpr int LDZ = 5184;
constexpr int ZU = 0, ZQ = 1024, ZK = 1536, ZV = 2048, ZGP = 3072, ZGG = 4096, ZLR = 5120;
constexpr int NIN = 5136, NINP = 5376;
constexpr int NM = M / 256;
constexpr float EPS = 1e-6f;
constexpr size_t O_Y = 0, O_NPP = (size_t)M * DM, O_NGP = O_NPP + 16 * 15 * 1024, O_NPS = O_NGP + 16 * 4 * 128 * 256, O_NGS = O_NPS + 16 * 15 * 1024, O_END = O_NGS + 16 * 4 * 128 * 256;

constexpr size_t MiB = 1u << 20;
constexpr size_t WS_CTL = 0, CTL_ZERO_BYTES = 48 * 1024;
constexpr size_t WS_WIN = 2 * MiB;
constexpr size_t WS_WOUT = 13 * MiB;
constexpr size_t WS_WP = 17 * MiB;
constexpr size_t WS_PART = 18 * MiB;
constexpr size_t WS_XN = 24 * MiB;
constexpr size_t WS_Z = 96 * MiB;
constexpr size_t WS_ZEND = WS_Z + (size_t)M * LDZ * 2;
constexpr size_t WS_SLOC = 432 * MiB;
constexpr size_t WS_BSEG = 457 * MiB;
constexpr size_t WS_SLAB = 460 * MiB;
constexpr size_t WS_END = 476 * MiB;
static_assert(WS_ZEND <= WS_SLOC && WS_SLOC + 192ull * 131072 <= WS_BSEG, "ws map 2");
static_assert(WS_WIN + (size_t)NINP * 1024 * 2 <= WS_WOUT && WS_PART + (size_t)M * 64 <= WS_XN && WS_XN + (size_t)M * 2048 <= WS_Z, "ws map");
constexpr int CW_BAR = 0;

constexpr int RING_BYTES = 131072;
constexpr int PU_STG = 65536, PU_STG_BYTES = 144 * 512;
constexpr int CTL_BASE = PU_STG + PU_STG_BYTES;
constexpr int LDSCTL_OFF = CTL_BASE, MISC_OFF = LDSCTL_OFF + 320;
constexpr int LDS_BYTES = CTL_BASE + 16384;

#define GAS __attribute__((address_space(1)))
#define LAS __attribute__((address_space(3)))
typedef unsigned short bf16;
typedef unsigned v4u __attribute__((ext_vector_type(4)));
typedef unsigned v2u __attribute__((ext_vector_type(2)));
typedef float f32x2v __attribute__((ext_vector_type(2)));
typedef float f32x4 __attribute__((ext_vector_type(4)));
typedef float f32x16 __attribute__((ext_vector_type(16)));
typedef short bf16x8 __attribute__((ext_vector_type(8)));
typedef GAS unsigned gu32;
#define RLX_AGENT __ATOMIC_RELAXED, __HIP_MEMORY_SCOPE_AGENT
#define LDS_WAIT() asm volatile("s_waitcnt lgkmcnt(0)" ::: "memory")
__device__ __forceinline__ unsigned f2bf(float f) { unsigned u = __builtin_bit_cast(unsigned, f); return (u + 0x7fffu + ((u >> 16) & 1u)) >> 16; }
__device__ __forceinline__ unsigned pk2(float lo, float hi) { return f2bf(lo) | (f2bf(hi) << 16); }
__device__ __forceinline__ float bf2f(unsigned u16) { return __builtin_bit_cast(float, u16 << 16); }
__device__ __forceinline__ float bflo(unsigned w) { return __builtin_bit_cast(float, w << 16); }
__device__ __forceinline__ float bfhi(unsigned w) { return __builtin_bit_cast(float, w & 0xffff0000u); }
__device__ __forceinline__ float silu_f(float x) { return x * __builtin_amdgcn_rcpf(1.0f + __expf(-x)); }

#define XB_TMO      128
#define XB_XCNT(j)  (256  + 64 * (j))
#define XB_XSUB(j)  (1280 + 64 * (j))
#define XB_XGEN(j)  (2304 + 64 * (j))
#define XB_TOP      3328
#define XB_TOPGEN   3392
#define XCD_BAR_WORDS 3456
#define XB_SPIN_CAP (1u << 18)
__device__ __forceinline__ unsigned xb_ld(unsigned* p)              { return __hip_atomic_load(p, __ATOMIC_RELAXED, __HIP_MEMORY_SCOPE_AGENT); }
__device__ __forceinline__ unsigned xb_add(unsigned* p, unsigned v) { return __hip_atomic_fetch_add(p, v, __ATOMIC_RELAXED, __HIP_MEMORY_SCOPE_AGENT); }
__device__ __forceinline__ unsigned xb_xcc_id() { return (unsigned)__builtin_amdgcn_s_getreg((3 << 11) | 20) & 0xFu; }
#define XB_SPIN(cond, bar) do { unsigned _sp = 0; while (cond) { __builtin_amdgcn_s_sleep(1); \
    if ((++_sp & 255u) == 0u) { if (xb_ld(&(bar)[XB_TMO])) break; if (_sp > XB_SPIN_CAP) { atomicAdd(&(bar)[XB_TMO], 1u); break; } } } } while (0)
struct XcdBarrier { unsigned* bar; unsigned x; volatile LAS unsigned* st; };
__device__ __forceinline__ XcdBarrier xcd_barrier_post(unsigned* bar, volatile LAS unsigned* st) {
    XcdBarrier b; b.bar = bar; b.x = xb_xcc_id(); b.st = st;
    if (threadIdx.x == 0) (void)xb_add(&bar[XB_XCNT(b.x)], 1u);
    return b;
}
__device__ __forceinline__ void xcd_barrier_complete(unsigned* bar, unsigned x, unsigned& nloc, unsigned& nx) {
    const unsigned G = gridDim.x * gridDim.y * gridDim.z;
    unsigned sum, cnt, mine, sp = 0u;
    for (;;) {
        sum = 0u; cnt = 0u; mine = 0u;
#pragma unroll
        for (unsigned j = 0; j < 16; ++j) { const unsigned c = xb_ld(&bar[XB_XCNT(j)]); sum += c; cnt += (c > 0u) ? 1u : 0u; mine = (j == x) ? c : mine; }
        if (sum == G) break;
        __builtin_amdgcn_s_sleep(1);
        if ((++sp & 255u) == 0u) { if (xb_ld(&bar[XB_TMO])) break; if (sp > XB_SPIN_CAP) { atomicAdd(&bar[XB_TMO], 1u); break; } }
    }
    nloc = mine > 0u ? mine : 1u; nx = cnt > 0u ? cnt : 1u;
}
__device__ __forceinline__ void xcd_barrier(const XcdBarrier& b) {
    asm volatile("s_waitcnt vmcnt(0)" ::: "memory");
    __syncthreads();
    if (threadIdx.x == 0) {
        unsigned* bar = b.bar;
        __builtin_amdgcn_s_waitcnt(0);
        unsigned nloc = b.st[0], nx = b.st[1];
        if (nloc == 0u) { xcd_barrier_complete(bar, b.x, nloc, nx); b.st[0] = nloc; b.st[1] = nx; }
        const unsigned old = xb_add(&bar[XB_XSUB(b.x)], 1u);
        const unsigned gen = old / nloc;
        if (old + 1u == (gen + 1u) * nloc) {
            __builtin_amdgcn_fence(__ATOMIC_RELEASE, "agent");
            asm volatile("s_waitcnt vmcnt(0)" ::: "memory");
            const unsigned og = xb_add(&bar[XB_TOP], 1u);
            const unsigned tg = og / nx;
            if (og + 1u == (tg + 1u) * nx) xb_add(&bar[XB_TOPGEN], 1u);
            else XB_SPIN(xb_ld(&bar[XB_TOPGEN]) == tg, bar);
            __builtin_amdgcn_fence(__ATOMIC_ACQUIRE, "agent");
            xb_add(&bar[XB_XGEN(b.x)], 1u);
            asm volatile("s_waitcnt vmcnt(0)" ::: "memory");
        } else {
            XB_SPIN(xb_ld(&bar[XB_XGEN(b.x)]) == gen, bar);
            __builtin_amdgcn_fence(__ATOMIC_ACQUIRE, "agent");
            asm volatile("s_waitcnt vmcnt(0)" ::: "memory");
        }
    }
    __syncthreads();
}

struct EpiZ {
    static constexpr bool PERM = true;
    bf16* Z; const float* pscale;
    __device__ __forceinline__ void operator()(const f32x4 (&acc)[2][2][4][2], const pg8::Unit& u, int wr, int wc, int fr, int fq) const {
        const int row0 = u.pm * 256 + wr * 64 + fr, col0 = u.pn * 256 + wc * 32 + 8 * fq;
        const int pn = u.pn; const bool dosilu = (pn >= 12 && pn < 20), lr = (pn == 20);
        const float sc = (pn == 4 || pn == 5) ? 0.08838834764831845f : 1.0f;
#pragma unroll
        for (int ai = 0; ai < 2; ++ai)
#pragma unroll
            for (int m = 0; m < 4; ++m) { bf16* rowp = Z + (size_t)(row0 + ai * 128 + m * 16) * LDZ + col0;
#pragma unroll
                for (int bj = 0; bj < 2; ++bj) { f32x4 v0 = acc[ai][bj][m][0], v1 = acc[ai][bj][m][1];
                    if (dosilu) { v0 = (f32x4){silu_f(v0[0]), silu_f(v0[1]), silu_f(v0[2]), silu_f(v0[3])}; v1 = (f32x4){silu_f(v1[0]), silu_f(v1[1]), silu_f(v1[2]), silu_f(v1[3])}; }
                    v0 = v0 * sc; v1 = v1 * sc;
                    if (pn >= 12 && pn < 16) { v0 = v0 * *(const f32x4*)(pscale + col0 - ZGP + bj * 128); v1 = v1 * *(const f32x4*)(pscale + col0 - ZGP + bj * 128 + 4); }
                    v4u w; w.x = pg8::cvt_pk_bf16(v0[0], v0[1]); w.y = pg8::cvt_pk_bf16(v0[2], v0[3]); w.z = pg8::cvt_pk_bf16(v1[0], v1[1]); w.w = pg8::cvt_pk_bf16(v1[2], v1[3]);
                    if (!lr || (bj == 0 && wc == 0 && fq < 2)) *(v4u*)(rowp + bj * 128) = w; } }
    }
};
struct EpiPool {
    static constexpr bool PERM = true;
    bf16* Z;
    __device__ __forceinline__ void operator()(const f32x4 (&acc)[2][2][4][2], const pg8::Unit& u, int wr, int wc, int fr, int fq) const {
        const int row0 = u.pm * 256 + wr * 64 + fr, col0 = u.pn * 256 + wc * 32 + 8 * fq;
        bf16* base = Z + (size_t)row0 * LDZ + ZGP + col0;
#pragma unroll
        for (int ai = 0; ai < 2; ++ai)
#pragma unroll
          for (int mp = 0; mp < 2; ++mp) {
            v4u gs[2][2];
#pragma unroll
            for (int mm = 0; mm < 2; ++mm)
#pragma unroll
                for (int bj = 0; bj < 2; ++bj) gs[mm][bj] = *(const v4u*)(base + (size_t)(ai * 128 + (2 * mp + mm) * 16) * LDZ + bj * 128);
            __builtin_amdgcn_sched_barrier(0);
#pragma unroll
            for (int mm = 0; mm < 2; ++mm)
#pragma unroll
                for (int bj = 0; bj < 2; ++bj) { const int m = 2 * mp + mm; const v4u gsg = gs[mm][bj];
                    const f32x4 v0 = acc[ai][bj][m][0] * (f32x4){bflo(gsg.x), bfhi(gsg.x), bflo(gsg.y), bfhi(gsg.y)}, v1 = acc[ai][bj][m][1] * (f32x4){bflo(gsg.z), bfhi(gsg.z), bflo(gsg.w), bfhi(gsg.w)};
                    v4u w; w.x = pg8::cvt_pk_bf16(v0[0], v0[1]); w.y = pg8::cvt_pk_bf16(v0[2], v0[3]); w.z = pg8::cvt_pk_bf16(v1[0], v1[1]); w.w = pg8::cvt_pk_bf16(v1[2], v1[3]);
                    *(v4u*)(base + (size_t)(ai * 128 + m * 16) * LDZ + bj * 128) = w; }
            __builtin_amdgcn_sched_barrier(0);
          }
    }
};
struct OneUnit { int pm, pn; __device__ __forceinline__ bool next(int i, pg8::Unit& u) const { if (i) return false; u.pm = pm; u.pn = pn; return true; } };
struct EpiSlab {
    static constexpr bool PERM = false;
    float* slab;
    __device__ __forceinline__ void operator()(const f32x4 (&acc)[2][2][4][2], const pg8::Unit&, int wr, int wc, int fr, int fq) const {
#pragma unroll
        for (int ai = 0; ai < 2; ++ai)
#pragma unroll
            for (int m = 0; m < 4; ++m) { float* rowp = slab + (size_t)(ai * 128 + wr * 64 + m * 16 + fr) * 256 + wc * 32 + 4 * fq;
#pragma unroll
                for (int bj = 0; bj < 2; ++bj)
#pragma unroll
                    for (int n = 0; n < 2; ++n) *(f32x4*)(rowp + bj * 128 + n * 16) = acc[ai][bj][m][n]; }
    }
};
struct PanelOrder {
    int c, npanel;
    __device__ __forceinline__ bool next(int i, pg8::Unit& u) const { const int x = c & 7, y = c >> 3; const int p = i * 64 + x * 8 + (y >> 2); if (p >= npanel) return false; u.pm = p; u.pn = y & 3; return true; }
};
constexpr int CW_CNT = 3584;
constexpr int XL_OFF = CTL_BASE + 1024;
struct EpiRmsRes {
    static constexpr bool PERM = false;
    const float* xp; const float* xs; const float* gpost; float* out; float* xbuf; unsigned* cnt; LAS unsigned char* lds;
    __device__ __forceinline__ void operator()(const f32x4 (&acc)[2][2][4][2], const pg8::Unit& u, int wr, int wc, int fr, int fq) const {
        LAS float* P = (LAS float*)(lds + XL_OFF); LAS float* S = (LAS float*)(lds + XL_OFF + 4096); LAS unsigned* flag = (LAS unsigned*)(lds + XL_OFF + 5120);
        const int tid = threadIdx.x, wid = __builtin_amdgcn_readfirstlane(tid >> 6), lane = tid & 63;
        const int col0 = u.pn * 256 + wc * 32 + 4 * fq;
        const int prow0 = u.pm * 256;
        const float* xbase = prow0 < MP ? xp + (size_t)prow0 * DM : xs + (size_t)(prow0 - MP) * DM;
        f32x4 xa[2][2], xb[2][2];
#define RMS_LOADX(buf, grp) do { const size_t off_ = (size_t)(((grp) >> 2) * 128 + wr * 64 + ((grp) & 3) * 16 + fr) * DM + col0; \
            _Pragma("unroll") for (int bj = 0; bj < 2; ++bj) _Pragma("unroll") for (int n = 0; n < 2; ++n) buf[bj][n] = *(const f32x4*)(xbase + off_ + bj * 128 + n * 16); } while (0)
        RMS_LOADX(xa, 0); RMS_LOADX(xb, 1);
#pragma unroll
        for (int ai = 0; ai < 2; ++ai)
#pragma unroll
            for (int m = 0; m < 4; ++m) { float s = 0.f;
#pragma unroll
                for (int bj = 0; bj < 2; ++bj)
#pragma unroll
                    for (int n = 0; n < 2; ++n) { const f32x4 x = acc[ai][bj][m][n]; s += (x[0] * x[0] + x[1] * x[1]) + (x[2] * x[2] + x[3] * x[3]); }
                s += __shfl_xor(s, 16); s += __shfl_xor(s, 32);
                if (fq == 0) P[(ai * 128 + wr * 64 + m * 16 + fr) * 4 + wc] = s; }
        asm volatile("s_waitcnt lgkmcnt(0)" ::: "memory"); __builtin_amdgcn_s_barrier(); asm volatile("" ::: "memory");
        if (wid < 4) { const f32x4 p4 = *(const LAS f32x4*)(P + tid * 4); const float rs = (p4.x + p4.y) + (p4.z + p4.w);
            __hip_atomic_store((unsigned*)xbuf + (size_t)(prow0 + tid) * 4 + u.pn, __float_as_uint(rs), __ATOMIC_RELAXED, __HIP_MEMORY_SCOPE_AGENT);
            asm volatile("s_waitcnt vmcnt(0)" ::: "memory");
            if (lane == 0) __hip_atomic_fetch_add(cnt + 64 * u.pm, 1u, __ATOMIC_RELAXED, __HIP_MEMORY_SCOPE_AGENT); }
        if (wid == 0) { unsigned spins = 0;
            while ((unsigned)__builtin_amdgcn_readfirstlane(__hip_atomic_load(cnt + 64 * u.pm, __ATOMIC_RELAXED, __HIP_MEMORY_SCOPE_AGENT)) < 16u) { __builtin_amdgcn_s_sleep(2); if (++spins > (1u << 22)) break; }
            __builtin_amdgcn_fence(__ATOMIC_ACQUIRE, "agent");
            if (lane == 0) flag[0] = spins; }
        asm volatile("s_waitcnt vmcnt(0) lgkmcnt(0)" ::: "memory"); __builtin_amdgcn_s_barrier(); asm volatile("" ::: "memory");
        if (wid < 4) { const unsigned* slot = (const unsigned*)xbuf + (size_t)(prow0 + tid) * 4; float tot = 0.f;
#pragma unroll
            for (int t = 0; t < 4; ++t) tot += __uint_as_float(__hip_atomic_load(slot + t, __ATOMIC_RELAXED, __HIP_MEMORY_SCOPE_AGENT));
            S[tid] = __builtin_amdgcn_rsqf(tot * (1.0f / DM) + EPS); }
        asm volatile("s_waitcnt vmcnt(0) lgkmcnt(0)" ::: "memory"); __builtin_amdgcn_s_barrier(); asm volatile("" ::: "memory");
        f32x4 gp[2][2];
#pragma unroll
        for (int bj = 0; bj < 2; ++bj)
#pragma unroll
            for (int n = 0; n < 2; ++n) gp[bj][n] = *(const f32x4*)(gpost + col0 + bj * 128 + n * 16);
        float* obase = out + (size_t)prow0 * DM;
#define RMS_STORE(buf, grp) do { const int ai_ = (grp) >> 2, m_ = (grp) & 3; const int r_ = ai_ * 128 + wr * 64 + m_ * 16 + fr; const float rinv_ = S[r_]; const size_t off_ = (size_t)r_ * DM + col0; \
            _Pragma("unroll") for (int bj = 0; bj < 2; ++bj) _Pragma("unroll") for (int n = 0; n < 2; ++n) *(f32x4*)(obase + off_ + bj * 128 + n * 16) = buf[bj][n] + acc[ai_][bj][m_][n] * rinv_ * gp[bj][n]; } while (0)
#define SB __builtin_amdgcn_sched_barrier(0)
        RMS_STORE(xa, 0); SB; RMS_LOADX(xa, 2); SB; RMS_STORE(xb, 1); SB; RMS_LOADX(xb, 3); SB;
        RMS_STORE(xa, 2); SB; RMS_LOADX(xa, 4); SB; RMS_STORE(xb, 3); SB; RMS_LOADX(xb, 5); SB;
        RMS_STORE(xa, 4); SB; RMS_LOADX(xa, 6); SB; RMS_STORE(xb, 5); SB; RMS_LOADX(xb, 7); SB;
        RMS_STORE(xa, 6); SB; RMS_STORE(xb, 7);
#undef SB
#undef RMS_LOADX
#undef RMS_STORE
    }
};

struct Args { const float* in[13]; float* out; unsigned char* ws; int ph_lo, ph_hi; };
struct Frame {
    LAS unsigned char* lds;
    int tid, lane, wave, G;
};
#define A_XP(a) ((a).in[0])
#define A_XS(a) ((a).in[1])
#define A_SPOOL(a) ((a).in[2])
#define A_SGLA(a) ((a).in[3])
#define A_GPRE(a) ((a).in[4])
#define A_WIN(a) ((a).in[5])
#define A_WGU(a) ((a).in[6])
#define A_BGU(a) ((a).in[7])
#define A_WPOOL(a) ((a).in[8])
#define A_PSCALE(a) ((a).in[9])
#define A_GGO(a) ((a).in[10])
#define A_WOUT(a) ((a).in[11])
#define A_GPOST(a) ((a).in[12])
#define A_WINT(a) ((bf16*)((a).ws + WS_WIN))
#define A_WOUTT(a) ((bf16*)((a).ws + WS_WOUT))
#define A_WPT(a) ((bf16*)((a).ws + WS_WP))
#define A_XN(a) ((bf16*)((a).ws + WS_XN))
#define A_Z(a) ((bf16*)((a).ws + WS_Z))
#define A_PART(a) ((float*)((a).ws + WS_PART))
__device__ __forceinline__ float wave_sum(float v) {
#pragma unroll
    for (int o = 1; o < 64; o <<= 1) v += __shfl_xor(v, o);
    return v;
}
__device__ __forceinline__ const float* xrow(const Args& A, int m) { return m < MP ? A_XP(A) + (size_t)m * DM : A_XS(A) + (size_t)(m - MP) * DM; }

__device__ __forceinline__ void p0_transpose_item(const float* W, int K, int N, bf16* WT, int dstrow0, int nsrc0, int nvalid, int k0, LAS float* scr, int lane) {
    { f32x4 v[8]; const int n4 = (lane & 7) * 4;
#pragma unroll
      for (int i = 0; i < 8; ++i) { const int kk = 8 * i + (lane >> 3); v[i] = (n4 < nvalid) ? *(const f32x4*)(W + (size_t)(k0 + kk) * N + nsrc0 + n4) : (f32x4){0.f, 0.f, 0.f, 0.f}; }
#pragma unroll
      for (int i = 0; i < 8; ++i) { const int kk = 8 * i + (lane >> 3); LAS float* d = scr + kk * 33 + n4; d[0] = v[i].x; d[1] = v[i].y; d[2] = v[i].z; d[3] = v[i].w; } }
    LDS_WAIT(); asm volatile("" ::: "memory");
    const int c = lane & 7;
#pragma unroll
    for (int j = 0; j < 4; ++j) { const int n = (lane >> 3) + 8 * j; const LAS float* s = scr + (8 * c) * 33 + n;
        v4u o; o.x = pk2(s[0 * 33], s[1 * 33]); o.y = pk2(s[2 * 33], s[3 * 33]); o.z = pk2(s[4 * 33], s[5 * 33]); o.w = pk2(s[6 * 33], s[7 * 33]);
        *(GAS v4u*)(WT + (size_t)(dstrow0 + n) * K + k0 + 8 * c) = o; }
    LDS_WAIT(); asm volatile("" ::: "memory");
}
__device__ __forceinline__ void p0_prologue(Frame& F, const Args& A) {
    LAS float* scr = (LAS float*)(F.lds + F.wave * 16384);
    const int gw = blockIdx.x * NWAVES + F.wave, NGW = F.G * NWAVES;
    constexpr int I_IN = (1024 / 64) * (NINP / 32), I_OUT = (2048 / 64) * (1024 / 32), I_P = 4 * (256 / 64) * (256 / 32);
    f32x4 gp[4];
#pragma unroll
    for (int j = 0; j < 4; ++j) gp[j] = *((const f32x4*)A_GPRE(A) + F.lane + 64 * j);
    f32x4 c0[4], c1[4], n0[4], n1[4];
#define XN_LOAD(d0, d1, mm) do { const int m1_ = (mm) + NGW; const GAS f32x4* p0_ = (const GAS f32x4*)xrow(A, (mm) < M ? (mm) : gw) + F.lane; const GAS f32x4* p1_ = (const GAS f32x4*)xrow(A, m1_ < M ? m1_ : gw) + F.lane; \
        _Pragma("unroll") for (int j = 0; j < 4; ++j) d0[j] = p0_[64 * j]; _Pragma("unroll") for (int j = 0; j < 4; ++j) d1[j] = p1_[64 * j]; } while (0)
    XN_LOAD(c0, c1, gw);
    for (int it = gw; it < I_IN + I_OUT + I_P; it += NGW) {
        int r = it;
        if (r < I_IN) { const int nblk = NINP / 32, kb = r / nblk, nb = r % nblk, n0 = 32 * nb;
            int src = n0, nvalid = 32;
            if (n0 >= 1024 && n0 < 3072) src = n0 + 1024; else if (n0 >= 3072 && n0 < 4096) src = n0 - 2048;
            if (n0 == 5120) nvalid = 16; else if (n0 > 5120) { nvalid = 0; src = 0; }
            p0_transpose_item(A_WIN(A), 1024, NIN, A_WINT(A), n0, src, nvalid, 64 * kb, scr, F.lane); continue; }
        r -= I_IN;
        if (r < I_OUT) { const int nblk = 1024 / 32, kb = r / nblk, nb = r % nblk; p0_transpose_item(A_WOUT(A), 2048, 1024, A_WOUTT(A), 32 * nb, 32 * nb, 32, 64 * kb, scr, F.lane); continue; }
        r -= I_OUT;
        { const int gq = r / 32, rr = r % 32, kb = rr / 8, nb = rr % 8; p0_transpose_item(A_WPOOL(A) + (size_t)gq * 65536, 256, 256, A_WPT(A), gq * 256 + 32 * nb, 32 * nb, 32, 64 * kb, scr, F.lane); }
    }
    for (int m = gw; m < M; m += 2 * NGW) {
        const int m1 = m + NGW; const bool two = m1 < M;
        XN_LOAD(n0, n1, m + 2 * NGW);
        float s0 = 0.f, s1 = 0.f;
#pragma unroll
        for (int j = 0; j < 4; ++j) { s0 += (c0[j].x * c0[j].x + c0[j].y * c0[j].y) + (c0[j].z * c0[j].z + c0[j].w * c0[j].w); s1 += (c1[j].x * c1[j].x + c1[j].y * c1[j].y) + (c1[j].z * c1[j].z + c1[j].w * c1[j].w); }
        const float r0 = 1.0f / sqrtf(wave_sum(s0) * (1.f / DM) + EPS), r1 = 1.0f / sqrtf(wave_sum(s1) * (1.f / DM) + EPS);
        GAS unsigned long long* o0 = (GAS unsigned long long*)(A_XN(A) + (size_t)m * DM) + F.lane;
#pragma unroll
        for (int j = 0; j < 4; ++j) o0[64 * j] = (unsigned long long)pk2(c0[j].x * r0 * gp[j].x, c0[j].y * r0 * gp[j].y) | ((unsigned long long)pk2(c0[j].z * r0 * gp[j].z, c0[j].w * r0 * gp[j].w) << 32);
        if (two) { GAS unsigned long long* o1 = (GAS unsigned long long*)(A_XN(A) + (size_t)m1 * DM) + F.lane;
#pragma unroll
            for (int j = 0; j < 4; ++j) o1[64 * j] = (unsigned long long)pk2(c1[j].x * r1 * gp[j].x, c1[j].y * r1 * gp[j].y) | ((unsigned long long)pk2(c1[j].z * r1 * gp[j].z, c1[j].w * r1 * gp[j].w) << 32); }
#pragma unroll
        for (int j = 0; j < 4; ++j) { c0[j] = n0[j]; c1[j] = n1[j]; }
    }
#undef XN_LOAD
}

template <int w, int MODE>
__device__ __forceinline__ void poolgen_half(const LAS unsigned char* srow, const float* hist, LAS unsigned char* dA, LAS unsigned char* dB) {
#pragma unroll
    for (int sb = 0; sb < 2; ++sb) {
        unsigned outlo[8];
#pragma unroll
        for (int ep = 0; ep < 2; ++ep) {
            float a[23][2];
#pragma unroll
            for (int i = 0; i < 23; ++i) {
                if (i < 16 - w || (MODE == 1 && 8 * sb + i < 15)) { a[i][0] = 0.f; a[i][1] = 0.f; }
                else if (MODE == 2 && 8 * sb + i < 15) { const f32x2v hv = *(const f32x2v*)(hist + (8 * sb + i) * 1024 + 2 * ep); a[i][0] = hv.x; a[i][1] = hv.y; }
                else { const unsigned wv = *(const LAS unsigned*)(srow + (8 * sb + i) * 512 + 4 * ep); a[i][0] = bflo(wv); a[i][1] = bfhi(wv); } }
            float cur[8][2];
#pragma unroll
            for (int r = 0; r < 8; ++r) { cur[r][0] = a[15 + r][0]; cur[r][1] = a[15 + r][1]; }
#pragma unroll
            for (int i = 22; i >= 1; --i) { a[i][0] += a[i - 1][0]; a[i][1] += a[i - 1][1]; }
            if (w >= 4) {
#pragma unroll
                for (int i = 22; i >= 3; --i) { a[i][0] += a[i - 2][0]; a[i][1] += a[i - 2][1]; } }
            if (w >= 8) {
#pragma unroll
                for (int i = 22; i >= 7; --i) { a[i][0] += a[i - 4][0]; a[i][1] += a[i - 4][1]; } }
            if (w >= 16) {
#pragma unroll
                for (int i = 22; i >= 15; --i) { a[i][0] += a[i - 8][0]; a[i][1] += a[i - 8][1]; } }
#pragma unroll
            for (int r = 0; r < 8; ++r) { const float rc = 1.0f / (float)((MODE == 1 && 8 * sb + r + 1 < w) ? 8 * sb + r + 1 : w);
                const unsigned o = pg8::cvt_pk_bf16(a[15 + r][0] * rc - cur[r][0], a[15 + r][1] * rc - cur[r][1]);
                if (ep == 0) outlo[r] = o; else *(LAS v2u*)((sb ? dB : dA) + r * 64) = (v2u){outlo[r], o}; }
            __builtin_amdgcn_sched_barrier(0);
        }
    }
}
#define OPQ(x) asm volatile("" : "+v"(x))
__device__ __forceinline__ void pool_unit_of(int V, int& R0, int& g) { if (V < 1024) { g = V >> 8; R0 = ((V & 255) >> 1) * 256 + (V & 1) * 128; } else { const int s_ = V - 1024; g = (s_ >> 1) & 3; R0 = (128 + (s_ >> 3)) * 256 + (s_ & 1) * 128; } }
__device__ __forceinline__ void pool_run(Frame& F, const Args& A, int ubeg, int uend) {
    LAS unsigned char* lds = F.lds;
    const int wid = F.wave;
    if (ubeg >= uend) return;
    int R0, g; pool_unit_of(ubeg, R0, g);
    int gB = -1;
#define PU_DMA(R0x, gx) do { int ln_ = F.lane; OPQ(ln_); const char* zb_ = (const char*)A_Z(A) + ((long)((R0x) - 16 + 18 * wid) * LDZ + ZU + (gx) * 256) * 2; \
        const unsigned vo_ = (unsigned)((ln_ >> 5) * (LDZ * 2) + (ln_ & 31) * 16); \
        _Pragma("unroll") for (int q = 0; q < 9; ++q) __builtin_amdgcn_global_load_lds((const unsigned*)(zb_ + vo_ + q * (4 * LDZ)), (LAS unsigned*)(lds + PU_STG + (wid * 9 + q) * 1024), 16, 0, 0); } while (0)
    PU_DMA(R0, g);
    pg8::bf16x8 Bf[2][8];
    for (int nu = 0;; ++nu) {
        int R0n = R0, gn = g; const int un = ubeg + nu + 1; const bool hasn = un < uend; if (hasn) pool_unit_of(un, R0n, gn);
        asm volatile("s_waitcnt vmcnt(0)" ::: "memory"); __syncthreads();
        int lane = F.lane; OPQ(lane);
        const int fr = lane & 15, fq = lane >> 4;
        bf16* base = A_Z(A) + (size_t)(R0 + fr) * LDZ + ZGP + g * 256 + wid * 32 + 8 * fq;
        v4u gs[8];
#pragma unroll
        for (int m = 0; m < 8; ++m) gs[m] = *(const v4u*)(base + (size_t)(16 * m) * LDZ);
        const bf16* wb = A_WPT(A) + (size_t)(g * 256 + wid * 32 + 8 * (fr >> 2) + (fr & 3)) * 256 + 8 * fq;
        if (g != gB) { gB = g;
#pragma unroll
            for (int n = 0; n < 2; ++n)
#pragma unroll
                for (int kk = 0; kk < 8; ++kk) Bf[n][kk] = *(const pg8::bf16x8*)(wb + (4 * n) * 256 + 32 * kk); }
        __builtin_amdgcn_sched_barrier(0);
        { int ln = F.lane; OPQ(ln);
          const int row0 = R0 + wid * 16; const bool samp = row0 >= MP;
          int b, ts; if (!samp) { b = row0 / TP; ts = row0 % TP; } else { b = (row0 - MP) / TS; ts = (row0 - MP) % TS; }
          const int w = 2 << g, c0 = g * 256 + 4 * ln;
          LAS unsigned char* dA = lds + (ln >> 4) * 16384 + (wid * 2 + ((ln >> 3) & 1)) * 1024 + 8 * (ln & 7);
          LAS unsigned char* dB = lds + (ln >> 4) * 16384 + (wid * 2 + ((ln >> 3) & 1)) * 1024 + 512 + ((8 * (ln & 7)) ^ 32);
          const LAS unsigned char* srow = lds + PU_STG + (16 * wid + 1) * 512 + 8 * ln;
          const float* hist = A_SPOOL(A) + (size_t)b * 15 * 1024 + c0;
          const int mode = ts >= 15 ? 0 : (samp ? 2 : 1);
#define PU_GEN(W) do { if (mode == 0) poolgen_half<W, 0>(srow, hist, dA, dB); else if (mode == 1) poolgen_half<W, 1>(srow, hist, dA, dB); else poolgen_half<W, 2>(srow, hist, dA, dB); } while (0)
          if (w == 2) PU_GEN(2); else if (w == 4) PU_GEN(4); else if (w == 8) PU_GEN(8); else PU_GEN(16);
#undef PU_GEN
        }
        __builtin_amdgcn_sched_barrier(0);
#pragma unroll
        for (int m = 0; m < 8; ++m) asm volatile("" : "+v"(gs[m]));
#pragma unroll
        for (int n = 0; n < 2; ++n)
#pragma unroll
            for (int kk = 0; kk < 8; ++kk) asm volatile("" : "+v"(Bf[n][kk]));
        f32x4 acc[8][2];
#pragma unroll
        for (int m = 0; m < 8; ++m)
#pragma unroll
            for (int n = 0; n < 2; ++n) acc[m][n] = (f32x4){0.f, 0.f, 0.f, 0.f};
        LDS_WAIT(); asm volatile("" ::: "memory");
        __builtin_amdgcn_s_barrier();
        asm volatile("" ::: "memory");
        PU_DMA(R0n, gn);
        __builtin_amdgcn_sched_barrier(0);
        const int aoff = pg8::lds_byte(fr, fq * 8);
#pragma unroll
        for (int t = 0; t < 4; ++t)
#pragma unroll
            for (int mh = 0; mh < 2; ++mh) {
                pg8::bf16x8 At[4][2];
#pragma unroll
                for (int m = 0; m < 4; ++m)
#pragma unroll
                    for (int kk = 0; kk < 2; ++kk) At[m][kk] = *(const LAS pg8::bf16x8*)(lds + t * 16384 + aoff + (4 * mh + m) * 2048 + kk * 1024);
#pragma unroll
                for (int m = 0; m < 4; ++m)
#pragma unroll
                    for (int n = 0; n < 2; ++n)
#pragma unroll
                        for (int kk = 0; kk < 2; ++kk) acc[4 * mh + m][n] = __builtin_amdgcn_mfma_f32_16x16x32_bf16(Bf[n][2 * t + kk], At[m][kk], acc[4 * mh + m][n], 0, 0, 0);
            }
#pragma unroll
        for (int m = 0; m < 8; ++m) { const v4u gsg = gs[m];
            const f32x4 v0 = acc[m][0] * (f32x4){bflo(gsg.x), bfhi(gsg.x), bflo(gsg.y), bfhi(gsg.y)}, v1 = acc[m][1] * (f32x4){bflo(gsg.z), bfhi(gsg.z), bflo(gsg.w), bfhi(gsg.w)};
            v4u o; o.x = pg8::cvt_pk_bf16(v0[0], v0[1]); o.y = pg8::cvt_pk_bf16(v0[2], v0[3]); o.z = pg8::cvt_pk_bf16(v1[0], v1[1]); o.w = pg8::cvt_pk_bf16(v1[2], v1[3]);
            *(v4u*)(base + (size_t)(16 * m) * LDZ) = o; }
        if (!hasn) break;
        R0 = R0n; g = gn;
    }
#undef PU_DMA
    asm volatile("s_waitcnt vmcnt(0)" ::: "memory"); __syncthreads();
}
__device__ __forceinline__ void newpool_copy(Frame& F, const Args& A) {
    const int gw = blockIdx.x * NWAVES + F.wave, NGW = F.G * NWAVES;
    for (int r = gw; r < 32 * 15; r += NGW) { const int s = r / 15, i = r % 15;
        const int src = s < 16 ? s * TP + (TP - 15) + i : MP + (s - 16) * TS + (TS - 15) + i;
        float* dst = A.out + (s < 16 ? O_NPP + (size_t)(s * 15 + i) * 1024 : O_NPS + (size_t)((s - 16) * 15 + i) * 1024);
        const bf16* sp = A_Z(A) + (size_t)src * LDZ + ZU;
#pragma unroll
        for (int j = 0; j < 2; ++j) { const int c = 8 * F.lane + 512 * j; const v4u w4 = *(const v4u*)(sp + c);
            *(f32x4*)(dst + c) = (f32x4){bflo(w4.x), bfhi(w4.x), bflo(w4.y), bfhi(w4.y)}; *(f32x4*)(dst + c + 4) = (f32x4){bflo(w4.z), bfhi(w4.z), bflo(w4.w), bfhi(w4.w)}; }
    }
}

constexpr int GL_GLRB = 0, GL_WGT = 2048, GL_BIAS = 6144, GL_GTOT = 6656, GL_DEXP = 7680, GL_PART = 8192, GL_GG = 10240, GL_QT = 11264, GL_KT = 28672, GL_OI = GL_QT, GL_VT = 46080, GL_VR = 82944, GL_KDT = GL_VR, GL_PP = GL_VR + 18432, GL_END = GL_VR + 33792;
static_assert(GL_END <= 131072 && GL_PP + 9216 <= GL_END && GL_OI + 64 * 264 * 2 <= GL_VT, "GLA LDS map");
template <bool SO>
__device__ __forceinline__ void gla_unit(Frame& F, const Args& A, int row0, int nchunk, int h, int nprev, const float* sprev, const float* bprev, bool raws, float* Sout, float* Bout) {
    LAS unsigned char* lds = F.lds;
    LAS unsigned char* GLRB = lds + GL_GLRB; LAS unsigned char* WGT = lds + GL_WGT; LAS float* BIAS = (LAS float*)(lds + GL_BIAS); LAS float* GTOT = (LAS float*)(lds + GL_GTOT);
    LAS float* DEXP = (LAS float*)(lds + GL_DEXP); LAS float* PART = (LAS float*)(lds + GL_PART); LAS float* GG = (LAS float*)(lds + GL_GG);
    LAS unsigned char* QT = lds + GL_QT; LAS unsigned char* KT = lds + GL_KT; LAS unsigned char* OI = lds + GL_OI; LAS unsigned char* KDT = lds + GL_KDT; LAS unsigned char* VT = lds + GL_VT; LAS unsigned char* PP = lds + GL_PP; LAS unsigned char* VR = lds + GL_VR;
    const int wid = F.wave;
    const bf16* Z = A_Z(A);
    { const int tid = F.tid, k = tid & 127, r4 = tid >> 7; const float* wp = A_WGU(A) + (size_t)(4 * r4) * 512 + h * 128 + k;
      *(LAS v2u*)(WGT + (k * 16 + 4 * r4) * 2) = (v2u){pk2(wp[0], wp[512]), pk2(wp[1024], wp[1536])};
      if (tid < 128) BIAS[tid] = A_BGU(A)[h * 128 + tid];
      if (tid < 256) GG[tid] = A_GGO(A)[tid]; }
    f32x16 S[4];
#pragma unroll
    for (int kb = 0; kb < 4; ++kb)
#pragma unroll
        for (int r = 0; r < 16; ++r) S[kb][r] = 0.f;
    for (int p = 0; p < nprev; ++p) { int ln = F.lane; OPQ(ln); const int hh = ln >> 5, l31 = ln & 31; const float* sp = sprev + (size_t)p * 32768; const float* bp = bprev + (size_t)p * 128;
        if (raws) {
#pragma unroll
            for (int kb = 0; kb < 4; ++kb)
#pragma unroll
                for (int r = 0; r < 16; ++r) { const int k = 32 * kb + (r & 3) + 8 * (r >> 2) + 4 * hh; S[kb][r] = sp[(size_t)k * 256 + 32 * wid + l31]; }
        } else {
#pragma unroll
            for (int kb = 0; kb < 4; ++kb)
#pragma unroll
                for (int g = 0; g < 4; ++g) { const f32x4 sv = *(const f32x4*)(sp + (size_t)(((wid * 4 + kb) * 4 + g) * 64 + ln) * 4); const f32x4 bv = *(const f32x4*)(bp + 32 * kb + 8 * g + 4 * hh);
                    S[kb][4 * g + 0] = S[kb][4 * g + 0] * __expf(bv.x) + sv.x; S[kb][4 * g + 1] = S[kb][4 * g + 1] * __expf(bv.y) + sv.y; S[kb][4 * g + 2] = S[kb][4 * g + 2] * __expf(bv.z) + sv.z; S[kb][4 * g + 3] = S[kb][4 * g + 3] * __expf(bv.w) + sv.w; }
        } }
    float bsum = 0.f;
    v4u rq[2], rk[2], rv[4], rg;
#define GLA_LOAD_RAW(zbase) do { int t_ = F.tid; OPQ(t_); \
        _Pragma("unroll") for (int i = 0; i < 2; ++i) { const int idx = t_ + 512 * i, row = idx >> 4, c8 = idx & 15; const unsigned off = (unsigned)((row * LDZ + ZQ + h * 128 + 8 * c8) * 2); if constexpr (!SO) rq[i] = *(const v4u*)((zbase) + off); rk[i] = *(const v4u*)((zbase) + off + (ZK - ZQ) * 2); } \
        _Pragma("unroll") for (int i = 0; i < 4; ++i) { const int idx = t_ + 512 * i, row = idx >> 5, c8 = idx & 31; rv[i] = *(const v4u*)((zbase) + (unsigned)((row * LDZ + ZV + h * 256 + 8 * c8) * 2)); } \
        if (t_ < 128) rg = *(const v4u*)((zbase) + (unsigned)(((t_ >> 1) * LDZ + ZLR + 8 * (t_ & 1)) * 2)); } while (0)
#define GLA_LOAD_QK(zbase) do { int t_ = F.tid; OPQ(t_); \
        _Pragma("unroll") for (int i = 0; i < 2; ++i) { const int idx = t_ + 512 * i, row = idx >> 4, c8 = idx & 15; const unsigned off = (unsigned)((row * LDZ + ZQ + h * 128 + 8 * c8) * 2); if constexpr (!SO) rq[i] = *(const v4u*)((zbase) + off); rk[i] = *(const v4u*)((zbase) + off + (ZK - ZQ) * 2); } \
        if (t_ < 128) rg = *(const v4u*)((zbase) + (unsigned)(((t_ >> 1) * LDZ + ZLR + 8 * (t_ & 1)) * 2)); } while (0)
#define GLA_LOAD_V(zbase) do { int t_ = F.tid; OPQ(t_); \
        _Pragma("unroll") for (int i = 0; i < 4; ++i) { const int idx = t_ + 512 * i, row = idx >> 5, c8 = idx & 31; rv[i] = *(const v4u*)((zbase) + (unsigned)((row * LDZ + ZV + h * 256 + 8 * c8) * 2)); } } while (0)
    { const char* z0 = (const char*)Z + (size_t)row0 * (LDZ * 2); GLA_LOAD_RAW(z0); }
    __syncthreads();

    for (int c = 0; c < nchunk; ++c) {
        const char* zc = (const char*)Z + (size_t)(row0 + 64 * c) * (LDZ * 2);
        { int tid = F.tid; OPQ(tid);
#pragma unroll
          for (int i = 0; i < 2; ++i) { const int idx = tid + 512 * i, row = idx >> 4, c8 = idx & 15; if constexpr (!SO) *(LAS v4u*)(QT + (row * 136 + 8 * c8) * 2) = rq[i]; *(LAS v4u*)(KT + (row * 136 + 8 * c8) * 2) = rk[i]; }
#pragma unroll
          for (int i = 0; i < 4; ++i) { const int idx = tid + 512 * i, row = idx >> 5, c8 = idx & 31; *(LAS v4u*)(VR + (row * 264 + 8 * c8) * 2) = rv[i]; }
          if (tid < 128) *(LAS v4u*)(GLRB + tid * 16) = rg; }
        __syncthreads();
        if (c + 1 < nchunk) { const char* zn = zc + (size_t)64 * (LDZ * 2); GLA_LOAD_QK(zn); }
        v4u sgv[4];
        { int tid = F.tid; OPQ(tid); const int vv = tid & 255, jh = tid >> 8;
#pragma unroll
          for (int q = 0; q < 4; ++q) { unsigned e[8];
#pragma unroll
              for (int x = 0; x < 8; ++x) e[x] = *(const LAS unsigned short*)(VR + ((32 * jh + 8 * q + x) * 264 + vv) * 2);
              *(LAS v4u*)(VT + (vv * 72 + 32 * jh + 8 * q) * 2) = (v4u){e[0] | (e[1] << 16), e[2] | (e[3] << 16), e[4] | (e[5] << 16), e[6] | (e[7] << 16)}; } }
        float pb[16];
        { int lane = F.lane; OPQ(lane); const int hh = lane >> 5, l31 = lane & 31; const int kb = wid & 3, jb = wid >> 2, k = 32 * kb + l31;
          const bf16x8 ga = *(const LAS bf16x8*)(GLRB + ((32 * jb + l31) * 16 + 8 * hh) * 2);
          const bf16x8 wb = *(const LAS bf16x8*)(WGT + (k * 16 + 8 * hh) * 2);
          f32x16 d;
#pragma unroll
          for (int r = 0; r < 16; ++r) d[r] = 0.f;
          d = __builtin_amdgcn_mfma_f32_32x32x16_bf16(ga, wb, d, 0, 0, 0);
          const float bias = BIAS[k];
          float gs[4], pgs[4];
#pragma unroll
          for (int g = 0; g < 4; ++g) { float run = 0.f;
#pragma unroll
              for (int e = 0; e < 4; ++e) { const float a = d[4 * g + e] + bias; const float la = (fminf(a, 0.f) - __logf(1.0f + __expf(-fabsf(a)))) * (1.0f / 16.0f); run += la; pb[4 * g + e] = run; }
              gs[g] = run; }
#pragma unroll
          for (int g = 0; g < 4; ++g) pgs[g] = __shfl_xor(gs[g], 32);
          float offs = 0.f;
#pragma unroll
          for (int g = 0; g < 4; ++g) { const float mine = offs + (hh ? pgs[g] : 0.f);
#pragma unroll
              for (int e = 0; e < 4; ++e) pb[4 * g + e] += mine;
              offs += gs[g] + pgs[g]; }
          if (hh == 0) GTOT[jb * 128 + k] = offs; }
        __syncthreads();
        if (c + 1 < nchunk) { const char* zn = zc + (size_t)64 * (LDZ * 2); GLA_LOAD_V(zn); }
        { int lane = F.lane; OPQ(lane); const int hh = lane >> 5, l31 = lane & 31; const int kb = wid & 3, jb = wid >> 2, k = 32 * kb + l31;
          const float t0 = GTOT[k], t1 = GTOT[128 + k]; const float bend = t0 + t1, joff = jb ? t0 : 0.f; const float ebend = __expf(bend);
          bsum += bend;
#pragma unroll
          for (int g = 0; g < 4; ++g) { float kdv[4];
#pragma unroll
              for (int e = 0; e < 4; ++e) { const int j = 32 * jb + 8 * g + 4 * hh + e; const float b = pb[4 * g + e] + joff;
                  LAS unsigned short* kp = (LAS unsigned short*)(KT + (j * 136 + k) * 2); const float kk = bf2f(*kp);
                  if constexpr (!SO) { LAS unsigned short* qp = (LAS unsigned short*)(QT + (j * 136 + k) * 2); const float q = bf2f(*qp);
                      const float qt = q * __expf(b), kt = kk * __expf(-b); kdv[e] = kt * ebend;
                      const unsigned w = pg8::cvt_pk_bf16(qt, kt); *qp = (unsigned short)w; *kp = (unsigned short)(w >> 16); }
                  else kdv[e] = kk * __expf(bend - b); }
              *(LAS v2u*)(KDT + (k * 72 + 32 * jb + 8 * g + 4 * hh) * 2) = (v2u){pg8::cvt_pk_bf16(kdv[0], kdv[1]), pg8::cvt_pk_bf16(kdv[2], kdv[3])}; }
          if (jb == 0 && hh == 0) DEXP[k] = ebend; }
        __syncthreads();
        f32x16 o[2];
        if constexpr (!SO) {
        { int tid = F.tid; OPQ(tid);
#pragma unroll
          for (int n = 0; n < 4; ++n) { const int idx = tid + 512 * n, row = idx >> 5, c8 = idx & 31; sgv[n] = *(const v4u*)(zc + (unsigned)((row * LDZ + ZGG + h * 256 + 8 * c8) * 2)); } }
        if (wid < 3) { int lane = F.lane; OPQ(lane); const int hh = lane >> 5, l31 = lane & 31;
            const int jb = (wid == 2) ? 1 : 0, ib = (wid >= 1) ? 1 : 0;
            f32x16 sc;
#pragma unroll
            for (int r = 0; r < 16; ++r) sc[r] = 0.f;
#pragma unroll
            for (int s = 0; s < 8; ++s) { const bf16x8 a = *(const LAS bf16x8*)(KT + ((32 * jb + l31) * 136 + 16 * s + 8 * hh) * 2); const bf16x8 bq = *(const LAS bf16x8*)(QT + ((32 * ib + l31) * 136 + 16 * s + 8 * hh) * 2);
                sc = __builtin_amdgcn_mfma_f32_32x32x16_bf16(a, bq, sc, 0, 0, 0); }
            const int i = 32 * ib + l31;
#pragma unroll
            for (int g = 0; g < 4; ++g) { const int j0 = 32 * jb + 8 * g + 4 * hh; float v[4];
#pragma unroll
                for (int e = 0; e < 4; ++e) v[e] = (i >= j0 + e) ? sc[4 * g + e] : 0.f;
                *(LAS v2u*)(PP + (i * 72 + j0) * 2) = (v2u){pg8::cvt_pk_bf16(v[0], v[1]), pg8::cvt_pk_bf16(v[2], v[3])}; } }
        { int lane = F.lane; OPQ(lane); const int hh = lane >> 5, l31 = lane & 31;
#pragma unroll
          for (int ib = 0; ib < 2; ++ib)
#pragma unroll
            for (int r = 0; r < 16; ++r) o[ib][r] = 0.f;
#pragma unroll
          for (int kb = 0; kb < 4; ++kb)
#pragma unroll
            for (int s = 0; s < 2; ++s) {
                v4u af; af.x = pg8::cvt_pk_bf16(S[kb][8 * s + 0], S[kb][8 * s + 1]); af.y = pg8::cvt_pk_bf16(S[kb][8 * s + 2], S[kb][8 * s + 3]); af.z = pg8::cvt_pk_bf16(S[kb][8 * s + 4], S[kb][8 * s + 5]); af.w = pg8::cvt_pk_bf16(S[kb][8 * s + 6], S[kb][8 * s + 7]);
                const bf16x8 a = __builtin_bit_cast(bf16x8, af);
#pragma unroll
                for (int ib = 0; ib < 2; ++ib) { const LAS unsigned char* qp = QT + ((32 * ib + l31) * 136 + 32 * kb + 16 * s + 4 * hh) * 2;
                    const v2u lo = *(const LAS v2u*)qp, hi = *(const LAS v2u*)(qp + 16);
                    const bf16x8 bq = __builtin_bit_cast(bf16x8, ((v4u){lo.x, lo.y, hi.x, hi.y}));
                    o[ib] = __builtin_amdgcn_mfma_f32_32x32x16_bf16(a, bq, o[ib], 0, 0, 0); } } }
        __syncthreads();
        { int lane = F.lane; OPQ(lane); const int hh = lane >> 5, l31 = lane & 31;
#pragma unroll
          for (int s = 0; s < 4; ++s) { const bf16x8 a = *(const LAS bf16x8*)(VT + ((32 * wid + l31) * 72 + 16 * s + 8 * hh) * 2);
            if (s < 2) { const bf16x8 b0 = *(const LAS bf16x8*)(PP + (l31 * 72 + 16 * s + 8 * hh) * 2); o[0] = __builtin_amdgcn_mfma_f32_32x32x16_bf16(a, b0, o[0], 0, 0, 0); }
            const bf16x8 b1 = *(const LAS bf16x8*)(PP + ((32 + l31) * 72 + 16 * s + 8 * hh) * 2); o[1] = __builtin_amdgcn_mfma_f32_32x32x16_bf16(a, b1, o[1], 0, 0, 0); }
#pragma unroll
          for (int ib = 0; ib < 2; ++ib) { float ss = 0.f;
#pragma unroll
            for (int r = 0; r < 16; ++r) ss += o[ib][r] * o[ib][r];
            ss += __shfl_xor(ss, 32);
            if (hh == 0) PART[wid * 64 + 32 * ib + l31] = ss; }
#pragma unroll
          for (int ib = 0; ib < 2; ++ib)
#pragma unroll
            for (int g = 0; g < 4; ++g) { const f32x4 g4 = *(const LAS f32x4*)(GG + 32 * wid + 8 * g + 4 * hh);
                *(LAS v2u*)(OI + ((32 * ib + l31) * 264 + 32 * wid + 8 * g + 4 * hh) * 2) = (v2u){pg8::cvt_pk_bf16(o[ib][4 * g + 0] * g4.x, o[ib][4 * g + 1] * g4.y), pg8::cvt_pk_bf16(o[ib][4 * g + 2] * g4.z, o[ib][4 * g + 3] * g4.w)}; } }
        }
        { int lane = F.lane; OPQ(lane); const int hh = lane >> 5, l31 = lane & 31;
#pragma unroll
          for (int kb = 0; kb < 4; ++kb) {
#pragma unroll
            for (int g = 0; g < 4; ++g) { const f32x4 d4 = *(const LAS f32x4*)(DEXP + 32 * kb + 8 * g + 4 * hh);
                S[kb][4 * g + 0] *= d4.x; S[kb][4 * g + 1] *= d4.y; S[kb][4 * g + 2] *= d4.z; S[kb][4 * g + 3] *= d4.w; }
#pragma unroll
            for (int s = 0; s < 4; ++s) { const bf16x8 a = *(const LAS bf16x8*)(KDT + ((32 * kb + l31) * 72 + 16 * s + 8 * hh) * 2); const bf16x8 bv = *(const LAS bf16x8*)(VT + ((32 * wid + l31) * 72 + 16 * s + 8 * hh) * 2);
                S[kb] = __builtin_amdgcn_mfma_f32_32x32x16_bf16(a, bv, S[kb], 0, 0, 0); } } }
        if constexpr (!SO) {
        __syncthreads();
        { int tid = F.tid; OPQ(tid);
#pragma unroll
          for (int n = 0; n < 4; ++n) { const int idx = tid + 512 * n, row = idx >> 5, c8 = idx & 31; const v4u ov = *(const LAS v4u*)(OI + (row * 264 + 8 * c8) * 2); const v4u gv = sgv[n];
              float tot = 0.f;
#pragma unroll
              for (int w8 = 0; w8 < 8; ++w8) tot += PART[w8 * 64 + row];
              const float rinv = __builtin_amdgcn_rsqf(tot * (1.0f / 256.0f) + EPS);
              v4u y; y.x = pg8::cvt_pk_bf16(bflo(ov.x) * rinv * bflo(gv.x), bfhi(ov.x) * rinv * bfhi(gv.x)); y.y = pg8::cvt_pk_bf16(bflo(ov.y) * rinv * bflo(gv.y), bfhi(ov.y) * rinv * bfhi(gv.y));
              y.z = pg8::cvt_pk_bf16(bflo(ov.z) * rinv * bflo(gv.z), bfhi(ov.z) * rinv * bfhi(gv.z)); y.w = pg8::cvt_pk_bf16(bflo(ov.w) * rinv * bflo(gv.w), bfhi(ov.w) * rinv * bfhi(gv.w));
              *(v4u*)((char*)zc + (unsigned)((row * LDZ + ZGG + h * 256 + 8 * c8) * 2)) = y; } }
        }
        __syncthreads();
    }
#undef GLA_LOAD_RAW
#undef GLA_LOAD_QK
#undef GLA_LOAD_V
    if (Sout) { int ln = F.lane; OPQ(ln); const int hh = ln >> 5, l31 = ln & 31;
      if constexpr (SO) {
#pragma unroll
        for (int kb = 0; kb < 4; ++kb)
#pragma unroll
          for (int g = 0; g < 4; ++g) *(f32x4*)(Sout + (size_t)(((wid * 4 + kb) * 4 + g) * 64 + ln) * 4) = (f32x4){S[kb][4 * g + 0], S[kb][4 * g + 1], S[kb][4 * g + 2], S[kb][4 * g + 3]};
      } else {
#pragma unroll
        for (int kb = 0; kb < 4; ++kb)
#pragma unroll
          for (int r = 0; r < 16; ++r) { const int k = 32 * kb + (r & 3) + 8 * (r >> 2) + 4 * hh; Sout[(size_t)k * 256 + 32 * wid + l31] = S[kb][r]; } } }
    if (Bout && wid < 4 && F.lane < 32) Bout[32 * wid + F.lane] = bsum;
    __syncthreads();
}

__global__ void __launch_bounds__(NWAVES * 64, 2) mk_fwd(Args A) {
    extern __shared__ __attribute__((aligned(16))) unsigned char lds[];
    Frame F;
    F.lds = (LAS unsigned char*)lds;
    F.tid = threadIdx.x; F.lane = F.tid & 63; F.wave = __builtin_amdgcn_readfirstlane(F.tid >> 6); F.G = gridDim.x;
#define REFRESH_F() do { int t_ = threadIdx.x; OPQ(t_); F.tid = t_; F.lane = t_ & 63; } while (0)
    const int lo = A.ph_lo, hi = A.ph_hi;
#ifndef PHASE_MASK
#define PHASE_MASK 63
#endif
#ifndef REPEAT_MASK
#define REPEAT_MASK 0
#endif
#define REP(k) (((REPEAT_MASK >> (k)) & 1) ? 2 : 1)
#define IN(k) (((PHASE_MASK >> (k)) & 1) && lo <= (k) && (k) < hi)
#define BOTH(k) (IN(k) && IN((k) + 1))
#if MK_N_LAUNCHES == 1
    for (int u = F.tid; u < (LDS_BYTES - LDSCTL_OFF) / 4; u += NWAVES * 64) ((LAS unsigned*)(F.lds + LDSCTL_OFF))[u] = 0u;
    __syncthreads();
    const XcdBarrier bar = xcd_barrier_post((unsigned*)(A.ws + WS_CTL) + CW_BAR, (volatile LAS unsigned*)(F.lds + MISC_OFF) + 8);
#define GRID_BAR0() xcd_barrier(bar)
#define GRID_BAR() xcd_barrier(bar)
#else
#define GRID_BAR0() do {} while (0)
#define GRID_BAR() do {} while (0)
#endif
    if (IN(0)) { for (int rep = 0; rep < REP(0); ++rep) p0_prologue(F, A); if (BOTH(0)) GRID_BAR0(); }
    if (IN(1)) for (int rep = 0; rep < REP(1); ++rep) {
        pg8::Gemm g{A_XN(A), A_WINT(A), DM, DM, DM, 0}; pg8::StaticOrder S; S.init(NM, NINP / 256, F.G, (int)blockIdx.x);
        EpiZ E{A_Z(A), A_PSCALE(A)};
        pg8::gemm_phase<EpiZ, pg8::StaticOrder, true>(F.lds, g, S, E);
        REFRESH_F();
        if (BOTH(1)) GRID_BAR();
    }
    if (IN(3)) {
        float* SLOC = (float*)(A.ws + WS_SLOC); float* BSEG = (float*)(A.ws + WS_BSEG);
        newpool_copy(F, A);
        const int G = F.G, blk = (int)blockIdx.x;
        const bool pool_first = blk < 192 && (blk & 1);
#define P3A_GLA() do { for (int u = blk; u < 256; u += G) { \
                if (u < 192) { const int b = u / 12, h = (u % 12) / 3, seg = u % 3; \
                    gla_unit<true>(F, A, b * TP + seg * 512, 8, h, 0, nullptr, nullptr, false, SLOC + (size_t)u * 32768, BSEG + (size_t)u * 128); } \
                else { const int us = u - 192, b = us >> 2, h = us & 3; \
                    gla_unit<false>(F, A, MP + b * TS, 1, h, 1, A_SGLA(A) + (size_t)us * 32768, A_BGU(A), true, A.out + O_NGS + (size_t)us * 32768, nullptr); } } } while (0)
#define P3A_POOL() do { int ub, ue; if (blk < 192) { ub = (blk >> 6) * 256 + (blk & 63) * 4; ue = ub + 4; } else { const int k = blk - 192; if (k < 56) { ub = 768 + (k < 32 ? 5 * k : 160 + 4 * (k - 32)); ue = ub + (k < 32 ? 5 : 4); } else { ub = 1024 + 4 * (k - 56); ue = ub + 4; } } \
            if (G == 256) pool_run(F, A, ub, ue); else if (blk == 0) pool_run(F, A, 0, NM * 8); REFRESH_F(); } while (0)
        if (pool_first) { P3A_POOL(); P3A_GLA(); } else { P3A_GLA(); P3A_POOL(); }
#undef P3A_GLA
#undef P3A_POOL
        REFRESH_F();
        GRID_BAR();
        if ((blk & 3) == 0) {
            const int q = blk >> 2, ks = q & 3;
            pg8::Gemm g{A_Z(A) + ZGP + 512 * ks, A_WOUTT(A) + 512 * ks, LDZ, 2048, 512, 0}; OneUnit S1{128 + (q >> 4), (q >> 2) & 3};
            EpiSlab E{(float*)(A.ws + WS_SLAB) + (size_t)q * 65536};
            pg8::gemm_phase<EpiSlab, OneUnit, true>(F.lds, g, S1, E); REFRESH_F(); }
        for (int u = blk; u < 256; u += G) { const int b = u >> 4, h = (u >> 2) & 3, seg = u & 3; const int sl = (b * 4 + h) * 3;
            gla_unit<false>(F, A, b * TP + seg * 512, 8, h, seg, SLOC + (size_t)sl * 32768, BSEG + (size_t)sl * 128, false, seg == 3 ? A.out + O_NGP + (size_t)(b * 4 + h) * 32768 : nullptr, nullptr); }
        if (BOTH(3)) GRID_BAR();
    }
    if (IN(4)) {
        { const int gw = blockIdx.x * NWAVES + F.wave;
          if (gw < MS) { const int r = gw, pnl = r >> 8, rt = r & 255; const float* slab = (const float*)(A.ws + WS_SLAB);
            f32x4 raw[4]; float s2 = 0.f;
#pragma unroll
            for (int pn = 0; pn < 4; ++pn) { f32x4 a = (f32x4){0.f, 0.f, 0.f, 0.f};
#pragma unroll
                for (int ks = 0; ks < 4; ++ks) a = a + *(const f32x4*)(slab + (size_t)(((pnl * 4 + pn) * 4 + ks)) * 65536 + rt * 256 + 4 * F.lane);
                raw[pn] = a; s2 += (a.x * a.x + a.y * a.y) + (a.z * a.z + a.w * a.w); }
            const float rinv = 1.0f / sqrtf(wave_sum(s2) * (1.f / DM) + EPS);
#pragma unroll
            for (int pn = 0; pn < 4; ++pn) { const int c = pn * 256 + 4 * F.lane; const f32x4 xv = *(const f32x4*)(A_XS(A) + (size_t)r * DM + c), gp = *(const f32x4*)(A_GPOST(A) + c);
                *(f32x4*)(A.out + (size_t)(MP + r) * DM + c) = xv + raw[pn] * rinv * gp; } } }
        pg8::Gemm g{A_Z(A) + ZGP, A_WOUTT(A), LDZ, 2048, 2048, 0}; PanelOrder S{(int)blockIdx.x, 128};
        EpiRmsRes E{A_XP(A), A_XS(A), A_GPOST(A), A.out, A_PART(A), (unsigned*)(A.ws + WS_CTL) + CW_CNT, F.lds};
        pg8::gemm_phase<EpiRmsRes, PanelOrder, true>(F.lds, g, S, E);
    }
#undef IN
#undef BOTH
}

extern "C" void kernel_launch(void* const* d_in, const int* in_sizes, int n_in, void* d_out, int out_size, void* d_ws, size_t ws_size, hipStream_t stream) {
    static int grid = 0;
    if (grid == 0) {
        if (n_in != 13 || in_sizes[0] != MP * DM || (size_t)out_size != O_END || ws_size < WS_END) {
            fprintf(stderr, "kernel_launch: unexpected shapes: n_in %d in0 %d out %d ws %zu (need %zu)\n", n_in, n_in > 0 ? in_sizes[0] : -1, out_size, ws_size, (size_t)WS_END); grid = -1; return; }
        int dev = 0, cus = 0, per_cu = 0;
        if (hipGetDevice(&dev) != hipSuccess || hipDeviceGetAttribute(&cus, hipDeviceAttributeMultiprocessorCount, dev) != hipSuccess) { grid = -1; return; }
        if (hipFuncSetAttribute((const void*)mk_fwd, hipFuncAttributeMaxDynamicSharedMemorySize, LDS_BYTES) != hipSuccess) { fprintf(stderr, "kernel_launch: hipFuncSetAttribute failed\n"); grid = -1; return; }
        if (hipOccupancyMaxActiveBlocksPerMultiprocessor(&per_cu, (const void*)mk_fwd, NWAVES * 64, LDS_BYTES) != hipSuccess || per_cu < 1) { fprintf(stderr, "kernel_launch: occupancy query failed (%d)\n", per_cu); (void)hipGetLastError(); grid = -1; return; }
        if (cus != 256) { fprintf(stderr, "kernel_launch: built for a 256-CU device (got %d)\n", cus); grid = -1; return; }
        grid = cus;
    }
    if (grid < 0) return;
    (void)hipMemsetAsync((char*)d_ws + WS_CTL, 0, CTL_ZERO_BYTES, stream);
    Args a{};
    for (int i = 0; i < 13; ++i) a.in[i] = (const float*)d_in[i];
    a.out = (float*)d_out; a.ws = (unsigned char*)d_ws;
#if MK_N_LAUNCHES == 1
    a.ph_lo = 0; a.ph_hi = 6;
    void* kargs[] = {&a};
    hipError_t e = hipLaunchCooperativeKernel((const void*)mk_fwd, dim3(grid), dim3(NWAVES * 64), kargs, LDS_BYTES, stream);
    if (e != hipSuccess) fprintf(stderr, "cooperative launch failed: %s (grid %d)\n", hipGetErrorString(e), grid);
#else
    for (int li = 0; li < 6; ++li) { a.ph_lo = li; a.ph_hi = li + 1; hipLaunchKernelGGL(mk_fwd, dim3(grid), dim3(NWAVES * 64), LDS_BYTES, stream, a); }
#endif
}
```

```cpp
#include <hip/hip_runtime.h>
#include <hip/hip_cooperative_groups.h>
#include <cstdio>
#include <cstdint>
namespace cg = cooperative_groups;

#ifndef MK_N_LAUNCHES
#define MK_N_LAUNCHES 1
#endif

namespace pg8 {
#define PG8_LAS __attribute__((address_space(3)))
typedef unsigned short bf16_t;
typedef short bf16x8 __attribute__((ext_vector_type(8)));
typedef float f32x4 __attribute__((ext_vector_type(4)));
typedef unsigned u32x4 __attribute__((ext_vector_type(4)));
constexpr int BM = 256, BK = 64, HALF = 128, HTB = HALF * BK * 2  , STAGE_BYTES = 8 * HTB, NXCD = 8, WGM = 8;

__host__ __device__ __forceinline__ int lds_byte(int r, int c) { const int st = (r >> 4) * 2 + (c >> 5), rr = r & 15, cc = c & 31, ob = rr * 64 + cc * 2; return st * 1024 + (ob ^ (((ob >> 9) & 1) << 5)); }
__host__ __device__ __forceinline__ void stage_rc(int b, int& R, int& C) { const int st = b / 1024, sb = b % 1024, swz = sb ^ (((sb >> 9) & 1) << 5); R = (st >> 1) * 16 + swz / 64; C = (st & 1) * 32 + (swz % 64) / 2; }
__host__ __device__ __forceinline__ int perm32(int rho) { const int n = rho >> 4, i = rho & 15; return 8 * (i >> 2) + 4 * n + (i & 3); }

struct Unit { int pm, pn; };
struct Gemm { const bf16_t* A; const bf16_t* Bt; int lda, ldb, K, aShift; };

struct StaticOrder {
    int nM, nN, nwg, G, c;
    __host__ __device__ __forceinline__ void init(int nM_, int nN_, int G_, int c_) { nM = nM_; nN = nN_; nwg = nM * nN; G = G_; c = c_; }
    __host__ __device__ __forceinline__ bool next(int i, Unit& u) const {
        const long L = (long)i * G + c; if (L >= nwg) return false;
        int wgid = (int)L; { const int q = nwg / NXCD, r = nwg % NXCD, xcd = wgid % NXCD, off = wgid / NXCD; wgid = (xcd < r ? xcd * (q + 1) : r * (q + 1) + (xcd - r) * q) + off; }
        const int nig = WGM * nN, gid = wgid / nig, fm = gid * WGM, gsz = (nM - fm) < WGM ? (nM - fm) : WGM;
        u.pm = fm + ((wgid % nig) % gsz); u.pn = (wgid % nig) / gsz; return true;
    }
};

__device__ __forceinline__ unsigned cvt_pk_bf16(float lo, float hi) { unsigned r; asm volatile("v_cvt_pk_bf16_f32 %0, %1, %2" : "=v"(r) : "v"(lo), "v"(hi)); return r; }

template <class Epi, class Sched, bool ALIGN_EPI>
__device__ __forceinline__ void gemm_phase(PG8_LAS unsigned char* lds, const Gemm g, const Sched& S, const Epi& E) {
    int tid_ = threadIdx.x; asm volatile("" : "+v"(tid_));
    const int tid = tid_, wid = __builtin_amdgcn_readfirstlane(tid >> 6), lane = tid & 63, wr = wid >> 2, wc = wid & 3, fr = lane & 15, fq = lane >> 4;
    const int K = g.K, nt = K / BK;
    unsigned voffA[2], voffB[2];
#pragma unroll
    for (int i = 0; i < 2; ++i) { int R, C; stage_rc(tid * 16 + i * 8192, R, C); const int Rb = Epi::PERM ? ((R & ~31) + perm32(R & 31)) : R;
        voffA[i] = (unsigned)(R * g.lda + C) * 2u; voffB[i] = (unsigned)(Rb * g.ldb + C) * 2u; }
    const size_t kstep = (size_t)(BK * 2);
    const size_t hstepA = (size_t)HALF * g.lda * 2, hstepB = (size_t)HALF * g.ldb * 2;
    const size_t tstepA = 2 * hstepA, tstepB = 2 * hstepB;
    const unsigned ldsw = (unsigned)wid * 1024u;
    const int aoff = lds_byte(wr * 64 + fr, fq * 8), boff = lds_byte(wc * 32 + fr, fq * 8);
#define PG8_SA(b, h) (((b) * 2 + (h)) * HTB)
#define PG8_SB(b, h) ((4 + (b) * 2 + (h)) * HTB)
#define PG8_STAGE(bufoff, gbase, voff) do { _Pragma("unroll") for (int _i = 0; _i < 2; ++_i) \
        __builtin_amdgcn_global_load_lds((const unsigned*)((const char*)(gbase) + (voff)[_i]), (PG8_LAS unsigned*)(lds + (bufoff) + ldsw + _i * 8192), 16, 0, 0); } while (0)
#define PG8_LDA(dst, b, h) do { _Pragma("unroll") for (int m = 0; m < 4; ++m) _Pragma("unroll") for (int k = 0; k < 2; ++k) dst[m][k] = *(const PG8_LAS bf16x8*)(lds + PG8_SA(b, h) + aoff + m * 2048 + k * 1024); } while (0)
#define PG8_LDB(dst, b, h) do { _Pragma("unroll") for (int n = 0; n < 2; ++n) _Pragma("unroll") for (int k = 0; k < 2; ++k) dst[n][k] = *(const PG8_LAS bf16x8*)(lds + PG8_SB(b, h) + boff + n * 2048 + k * 1024); } while (0)
#define PG8_MMA(ai, bj, At, Bt) do { __builtin_amdgcn_s_setprio(1); _Pragma("unroll") for (int m = 0; m < 4; ++m) _Pragma("unroll") for (int n = 0; n < 2; ++n) _Pragma("unroll") for (int k = 0; k < 2; ++k) \
        acc[ai][bj][m][n] = __builtin_amdgcn_mfma_f32_16x16x32_bf16(Bt[n][k], At[m][k], acc[ai][bj][m][n], 0, 0, 0); __builtin_amdgcn_s_setprio(0); } while (0)
#define PG8_WAIT_V(n) asm volatile("s_waitcnt vmcnt(" #n ")" ::: "memory")
#define PG8_WAIT_L(n) asm volatile("s_waitcnt lgkmcnt(" #n ")" ::: "memory")
#define PG8_BAR __builtin_amdgcn_s_barrier()
#define PG8_SCHED __builtin_amdgcn_sched_barrier(0)
    Unit cur, nxt; int ui = 0;
    if (!S.next(0, cur)) return;
    f32x4 acc[2][2][4][2];
#pragma unroll
    for (int a = 0; a < 2; ++a)
#pragma unroll
        for (int b = 0; b < 2; ++b)
#pragma unroll
            for (int m = 0; m < 4; ++m)
#pragma unroll
                for (int n = 0; n < 2; ++n) acc[a][b][m][n] = (f32x4){0.f, 0.f, 0.f, 0.f};
    bf16x8 At[4][2], B0[2][2], B1[2][2];
    const char* cA = (const char*)g.A + (size_t)cur.pm * tstepA + (size_t)cur.pn * g.aShift; const char* cB = (const char*)g.Bt + (size_t)cur.pn * tstepB;
    PG8_STAGE(PG8_SB(0, 0), cB, voffB); PG8_STAGE(PG8_SB(0, 1), cB + hstepB, voffB); PG8_STAGE(PG8_SA(0, 0), cA, voffA); PG8_STAGE(PG8_SA(0, 1), cA + hstepA, voffA);
    if (wr == 1) PG8_BAR;
    PG8_WAIT_V(2); PG8_BAR;
    PG8_STAGE(PG8_SB(1, 0), cB + kstep, voffB); PG8_STAGE(PG8_SA(1, 0), cA + kstep, voffA); PG8_STAGE(PG8_SB(1, 1), cB + hstepB + kstep, voffB);
    PG8_WAIT_V(6); PG8_BAR;
    for (;;) {
        const bool has_next = S.next(ui + 1, nxt);
        const char* nA = has_next ? (const char*)g.A + (size_t)nxt.pm * tstepA + (size_t)nxt.pn * g.aShift : cA; const char* nB = has_next ? (const char*)g.Bt + (size_t)nxt.pn * tstepB : cB;
        for (int t = 0; t < nt; t += 2) {
            const bool last = (t == nt - 2);
            const char* a1 = cA + (size_t)(t + 1) * kstep;
            const char* a2 = last ? nA : cA + (size_t)(t + 2) * kstep; const char* b2 = last ? nB : cB + (size_t)(t + 2) * kstep;
            const char* a3 = a2 + kstep; const char* b3 = b2 + kstep;
            PG8_LDB(B0, 0, 0); PG8_LDB(B1, 0, 1); PG8_SCHED; PG8_LDA(At, 0, 0); PG8_STAGE(PG8_SA(1, 1), a1 + hstepA, voffA);
            PG8_WAIT_V(8); PG8_WAIT_L(0); PG8_BAR; PG8_MMA(0, 0, At, B0); PG8_MMA(0, 1, At, B1); PG8_BAR; PG8_SCHED;
            PG8_LDA(At, 0, 1); PG8_STAGE(PG8_SB(0, 0), b2, voffB); PG8_STAGE(PG8_SB(0, 1), b2 + hstepB, voffB); PG8_STAGE(PG8_SA(0, 0), a2, voffA);
            PG8_WAIT_V(8); PG8_WAIT_L(0); PG8_BAR; PG8_MMA(1, 0, At, B0); PG8_MMA(1, 1, At, B1); PG8_BAR; PG8_SCHED;
            PG8_LDB(B0, 1, 0); PG8_LDB(B1, 1, 1); PG8_SCHED; PG8_LDA(At, 1, 0); PG8_STAGE(PG8_SA(0, 1), a2 + hstepA, voffA);
            PG8_WAIT_V(8); PG8_WAIT_L(0); PG8_BAR; PG8_MMA(0, 0, At, B0); PG8_MMA(0, 1, At, B1); PG8_BAR; PG8_SCHED;
            PG8_LDA(At, 1, 1); PG8_STAGE(PG8_SB(1, 0), b3, voffB); PG8_STAGE(PG8_SB(1, 1), b3 + hstepB, voffB); PG8_STAGE(PG8_SA(1, 0), a3, voffA);
            PG8_WAIT_V(8); PG8_WAIT_L(0); PG8_BAR; PG8_MMA(1, 0, At, B0); PG8_MMA(1, 1, At, B1); PG8_BAR; PG8_SCHED;
        }
        if constexpr (ALIGN_EPI) { if (wr == 0) PG8_BAR; }
        E(acc, cur, wr, wc, fr, fq);
        if (!has_next) break;
#pragma unroll
        for (int a = 0; a < 2; ++a)
#pragma unroll
            for (int b = 0; b < 2; ++b)
#pragma unroll
                for (int m = 0; m < 4; ++m)
#pragma unroll
                    for (int n = 0; n < 2; ++n) acc[a][b][m][n] = (f32x4){0.f, 0.f, 0.f, 0.f};
        cur = nxt; cA = nA; cB = nB; ++ui;
        if constexpr (ALIGN_EPI) { if (wr == 1) PG8_BAR; }
    }
    PG8_WAIT_V(0);
    if constexpr (!ALIGN_EPI) { if (wr == 0) PG8_BAR; }
    PG8_BAR;
#undef PG8_SA
#undef PG8_SB
#undef PG8_STAGE
#undef PG8_LDA
#undef PG8_LDB
#undef PG8_MMA
#undef PG8_WAIT_V
#undef PG8_WAIT_L
#undef PG8_BAR
#undef PG8_SCHED
}
}

constexpr int NWAVES = 8;
constexpr int DM = 1024, NBP = 16, TP = 2048, NBS = 16, TS = 64;
constexpr int MP = NBP * TP, MS = NBS * TS, M = MP + MS;
constexpr int LDZ = 5184;
constexpr int ZU = 0, ZQ = 1024, ZK = 1536, ZV = 2048, ZGP = 3072, ZGG = 4096, ZLR = 5120;
constexpr int NIN = 5136, NINP = 5376;
constexpr int NM = M / 256;
constexpr float EPS = 1e-6f;
constexpr size_t O_Y = 0, O_NPP = (size_t)M * DM, O_NGP = O_NPP + 16 * 15 * 1024, O_NPS = O_NGP + 16 * 4 * 128 * 256, O_NGS = O_NPS + 16 * 15 * 1024, O_END = O_NGS + 16 * 4 * 128 * 256;

constexpr size_t MiB = 1u << 20;
constexpr size_t WS_CTL = 0, CTL_ZERO_BYTES = 48 * 1024;
constexpr size_t WS_WIN = 2 * MiB;
constexpr size_t WS_WOUT = 13 * MiB;
constexpr size_t WS_WP = 17 * MiB;
constexpr size_t WS_PART = 18 * MiB;
constexpr size_t WS_XN = 24 * MiB;
constexpr size_t WS_Z = 96 * MiB;
constexpr size_t WS_ZEND = WS_Z + (size_t)M * LDZ * 2;
constexpr size_t WS_SLOC = 432 * MiB;
constexpr size_t WS_BSEG = 457 * MiB;
constexpr size_t WS_SLAB = 460 * MiB;
constexpr size_t WS_END = 476 * MiB;
static_assert(WS_ZEND <= WS_SLOC && WS_SLOC + 192ull * 131072 <= WS_BSEG, "ws map 2");
static_assert(WS_WIN + (size_t)NINP * 1024 * 2 <= WS_WOUT && WS_PART + (size_t)M * 64 <= WS_XN && WS_XN + (size_t)M * 2048 <= WS_Z, "ws map");
constexpr int CW_BAR = 0;

constexpr int RING_BYTES = 131072;
constexpr int PU_STG = 65536, PU_STG_BYTES = 144 * 512;
constexpr int CTL_BASE = PU_STG + PU_STG_BYTES;
constexpr int LDSCTL_OFF = CTL_BASE, MISC_OFF = LDSCTL_OFF + 320;
constexpr int LDS_BYTES = CTL_BASE + 16384;

#define GAS __attribute__((address_space(1)))
#define LAS __attribute__((address_space(3)))
typedef unsigned short bf16;
typedef unsigned v4u __attribute__((ext_vector_type(4)));
typedef unsigned v2u __attribute__((ext_vector_type(2)));
typedef float f32x2v __attribute__((ext_vector_type(2)));
typedef float f32x4 __attribute__((ext_vector_type(4)));
typedef float f32x16 __attribute__((ext_vector_type(16)));
typedef short bf16x8 __attribute__((ext_vector_type(8)));
typedef GAS unsigned gu32;
#define RLX_AGENT __ATOMIC_RELAXED, __HIP_MEMORY_SCOPE_AGENT
#define LDS_WAIT() asm volatile("s_waitcnt lgkmcnt(0)" ::: "memory")
__device__ __forceinline__ unsigned f2bf(float f) { unsigned u = __builtin_bit_cast(unsigned, f); return (u + 0x7fffu + ((u >> 16) & 1u)) >> 16; }
__device__ __forceinline__ unsigned pk2(float lo, float hi) { return f2bf(lo) | (f2bf(hi) << 16); }
__device__ __forceinline__ float bf2f(unsigned u16) { return __builtin_bit_cast(float, u16 << 16); }
__device__ __forceinline__ float bflo(unsigned w) { return __builtin_bit_cast(float, w << 16); }
__device__ __forceinline__ float bfhi(unsigned w) { return __builtin_bit_cast(float, w & 0xffff0000u); }
__device__ __forceinline__ float silu_f(float x) { return x * __builtin_amdgcn_rcpf(1.0f + __expf(-x)); }

#define XB_TMO      128
#define XB_XCNT(j)  (256  + 64 * (j))
#define XB_XSUB(j)  (1280 + 64 * (j))
#define XB_XGEN(j)  (2304 + 64 * (j))
#define XB_TOP      3328
#define XB_TOPGEN   3392
#define XCD_BAR_WORDS 3456
#define XB_SPIN_CAP (1u << 18)
__device__ __forceinline__ unsigned xb_ld(unsigned* p)              { return __hip_atomic_load(p, __ATOMIC_RELAXED, __HIP_MEMORY_SCOPE_AGENT); }
__device__ __forceinline__ unsigned xb_add(unsigned* p, unsigned v) { return __hip_atomic_fetch_add(p, v, __ATOMIC_RELAXED, __HIP_MEMORY_SCOPE_AGENT); }
__device__ __forceinline__ unsigned xb_xcc_id() { return (unsigned)__builtin_amdgcn_s_getreg((3 << 11) | 20) & 0xFu; }
#define XB_SPIN(cond, bar) do { unsigned _sp = 0; while (cond) { __builtin_amdgcn_s_sleep(1); \
    if ((++_sp & 255u) == 0u) { if (xb_ld(&(bar)[XB_TMO])) break; if (_sp > XB_SPIN_CAP) { atomicAdd(&(bar)[XB_TMO], 1u); break; } } } } while (0)
struct XcdBarrier { unsigned* bar; unsigned x; volatile LAS unsigned* st; };
__device__ __forceinline__ XcdBarrier xcd_barrier_post(unsigned* bar, volatile LAS unsigned* st) {
    XcdBarrier b; b.bar = bar; b.x = xb_xcc_id(); b.st = st;
    if (threadIdx.x == 0) (void)xb_add(&bar[XB_XCNT(b.x)], 1u);
    return b;
}
__device__ __forceinline__ void xcd_barrier_complete(unsigned* bar, unsigned x, unsigned& nloc, unsigned& nx) {
    const unsigned G = gridDim.x * gridDim.y * gridDim.z;
    unsigned sum, cnt, mine, sp = 0u;
    for (;;) {
        sum = 0u; cnt = 0u; mine = 0u;
#pragma unroll
        for (unsigned j = 0; j < 16; ++j) { const unsigned c = xb_ld(&bar[XB_XCNT(j)]); sum += c; cnt += (c > 0u) ? 1u : 0u; mine = (j == x) ? c : mine; }
        if (sum == G) break;
        __builtin_amdgcn_s_sleep(1);
        if ((++sp & 255u) == 0u) { if (xb_ld(&bar[XB_TMO])) break; if (sp > XB_SPIN_CAP) { atomicAdd(&bar[XB_TMO], 1u); break; } }
    }
    nloc = mine > 0u ? mine : 1u; nx = cnt > 0u ? cnt : 1u;
}
__device__ __forceinline__ void xcd_barrier(const XcdBarrier& b) {
    asm volatile("s_waitcnt vmcnt(0)" ::: "memory");
    __syncthreads();
    if (threadIdx.x == 0) {
        unsigned* bar = b.bar;
        __builtin_amdgcn_s_waitcnt(0);
        unsigned nloc = b.st[0], nx = b.st[1];
        if (nloc == 0u) { xcd_barrier_complete(bar, b.x, nloc, nx); b.st[0] = nloc; b.st[1] = nx; }
        const unsigned old = xb_add(&bar[XB_XSUB(b.x)], 1u);
        const unsigned gen = old / nloc;
        if (old + 1u == (gen + 1u) * nloc) {
            __builtin_amdgcn_fence(__ATOMIC_RELEASE, "agent");
            asm volatile("s_waitcnt vmcnt(0)" ::: "memory");
            const unsigned og = xb_add(&bar[XB_TOP], 1u);
            const unsigned tg = og / nx;
            if (og + 1u == (tg + 1u) * nx) xb_add(&bar[XB_TOPGEN], 1u);
            else XB_SPIN(xb_ld(&bar[XB_TOPGEN]) == tg, bar);
            __builtin_amdgcn_fence(__ATOMIC_ACQUIRE, "agent");
            xb_add(&bar[XB_XGEN(b.x)], 1u);
            asm volatile("s_waitcnt vmcnt(0)" ::: "memory");
        } else {
            XB_SPIN(xb_ld(&bar[XB_XGEN(b.x)]) == gen, bar);
            __builtin_amdgcn_fence(__ATOMIC_ACQUIRE, "agent");
            asm volatile("s_waitcnt vmcnt(0)" ::: "memory");
        }
    }
    __syncthreads();
}

struct EpiZ {
    static constexpr bool PERM = true;
    bf16* Z; const float* pscale;
    __device__ __forceinline__ void operator()(const f32x4 (&acc)[2][2][4][2], const pg8::Unit& u, int wr, int wc, int fr, int fq) const {
        const int row0 = u.pm * 256 + wr * 64 + fr, col0 = u.pn * 256 + wc * 32 + 8 * fq;
        const int pn = u.pn; const bool dosilu = (pn >= 12 && pn < 20), lr = (pn == 20);
        const float sc = (pn == 4 || pn == 5) ? 0.08838834764831845f : 1.0f;
#pragma unroll
        for (int ai = 0; ai < 2; ++ai)
#pragma unroll
            for (int m = 0; m < 4; ++m) { bf16* rowp = Z + (size_t)(row0 + ai * 128 + m * 16) * LDZ + col0;
#pragma unroll
                for (int bj = 0; bj < 2; ++bj) { f32x4 v0 = acc[ai][bj][m][0], v1 = acc[ai][bj][m][1];
                    if (dosilu) { v0 = (f32x4){silu_f(v0[0]), silu_f(v0[1]), silu_f(v0[2]), silu_f(v0[3])}; v1 = (f32x4){silu_f(v1[0]), silu_f(v1[1]), silu_f(v1[2]), silu_f(v1[3])}; }
                    v0 = v0 * sc; v1 = v1 * sc;
                    if (pn >= 12 && pn < 16) { v0 = v0 * *(const f32x4*)(pscale + col0 - ZGP + bj * 128); v1 = v1 * *(const f32x4*)(pscale + col0 - ZGP + bj * 128 + 4); }
                    v4u w; w.x = pg8::cvt_pk_bf16(v0[0], v0[1]); w.y = pg8::cvt_pk_bf16(v0[2], v0[3]); w.z = pg8::cvt_pk_bf16(v1[0], v1[1]); w.w = pg8::cvt_pk_bf16(v1[2], v1[3]);
                    if (!lr || (bj == 0 && wc == 0 && fq < 2)) *(v4u*)(rowp + bj * 128) = w; } }
    }
};
struct EpiPool {
    static constexpr bool PERM = true;
    bf16* Z;
    __device__ __forceinline__ void operator()(const f32x4 (&acc)[2][2][4][2], const pg8::Unit& u, int wr, int wc, int fr, int fq) const {
        const int row0 = u.pm * 256 + wr * 64 + fr, col0 = u.pn * 256 + wc * 32 + 8 * fq;
        bf16* base = Z + (size_t)row0 * LDZ + ZGP + col0;
#pragma unroll
        for (int ai = 0; ai < 2; ++ai)
#pragma unroll
          for (int mp = 0; mp < 2; ++mp) {
            v4u gs[2][2];
#pragma unroll
            for (int mm = 0; mm < 2; ++mm)
#pragma unroll
                for (int bj = 0; bj < 2; ++bj) gs[mm][bj] = *(const v4u*)(base + (size_t)(ai * 128 + (2 * mp + mm) * 16) * LDZ + bj * 128);
            __builtin_amdgcn_sched_barrier(0);
#pragma unroll
            for (int mm = 0; mm < 2; ++mm)
#pragma unroll
                for (int bj = 0; bj < 2; ++bj) { const int m = 2 * mp + mm; const v4u gsg = gs[mm][bj];
                    const f32x4 v0 = acc[ai][bj][m][0] * (f32x4){bflo(gsg.x), bfhi(gsg.x), bflo(gsg.y), bfhi(gsg.y)}, v1 = acc[ai][bj][m][1] * (f32x4){bflo(gsg.z), bfhi(gsg.z), bflo(gsg.w), bfhi(gsg.w)};
                    v4u w; w.x = pg8::cvt_pk_bf16(v0[0], v0[1]); w.y = pg8::cvt_pk_bf16(v0[2], v0[3]); w.z = pg8::cvt_pk_bf16(v1[0], v1[1]); w.w = pg8::cvt_pk_bf16(v1[2], v1[3]);
                    *(v4u*)(base + (size_t)(ai * 128 + m * 16) * LDZ + bj * 128) = w; }
            __builtin_amdgcn_sched_barrier(0);
          }
    }
};
struct OneUnit { int pm, pn; __device__ __forceinline__ bool next(int i, pg8::Unit& u) const { if (i) return false; u.pm = pm; u.pn = pn; return true; } };
struct EpiSlab {
    static constexpr bool PERM = false;
    float* slab;
    __device__ __forceinline__ void operator()(const f32x4 (&acc)[2][2][4][2], const pg8::Unit&, int wr, int wc, int fr, int fq) const {
#pragma unroll
        for (int ai = 0; ai < 2; ++ai)
#pragma unroll
            for (int m = 0; m < 4; ++m) { float* rowp = slab + (size_t)(ai * 128 + wr * 64 + m * 16 + fr) * 256 + wc * 32 + 4 * fq;
#pragma unroll
                for (int bj = 0; bj < 2; ++bj)
#pragma unroll
                    for (int n = 0; n < 2; ++n) *(f32x4*)(rowp + bj * 128 + n * 16) = acc[ai][bj][m][n]; }
    }
};
struct PanelOrder {
    int c, npanel;
    __device__ __forceinline__ bool next(int i, pg8::Unit& u) const { const int x = c & 7, y = c >> 3; const int p = i * 64 + x * 8 + (y >> 2); if (p >= npanel) return false; u.pm = p; u.pn = y & 3; return true; }
};
constexpr int CW_CNT = 3584;
constexpr int XL_OFF = CTL_BASE + 1024;
struct EpiRmsRes {
    static constexpr bool PERM = false;
    const float* xp; const float* xs; const float* gpost; float* out; float* xbuf; unsigned* cnt; LAS unsigned char* lds;
    __device__ __forceinline__ void operator()(const f32x4 (&acc)[2][2][4][2], const pg8::Unit& u, int wr, int wc, int fr, int fq) const {
        LAS float* P = (LAS float*)(lds + XL_OFF); LAS float* S = (LAS float*)(lds + XL_OFF + 4096); LAS unsigned* flag = (LAS unsigned*)(lds + XL_OFF + 5120);
        const int tid = threadIdx.x, wid = __builtin_amdgcn_readfirstlane(tid >> 6), lane = tid & 63;
        const int col0 = u.pn * 256 + wc * 32 + 4 * fq;
        const int prow0 = u.pm * 256;
        const float* xbase = prow0 < MP ? xp + (size_t)prow0 * DM : xs + (size_t)(prow0 - MP) * DM;
        f32x4 xa[2][2], xb[2][2];
#define RMS_LOADX(buf, grp) do { const size_t off_ = (size_t)(((grp) >> 2) * 128 + wr * 64 + ((grp) & 3) * 16 + fr) * DM + col0; \
            _Pragma("unroll") for (int bj = 0; bj < 2; ++bj) _Pragma("unroll") for (int n = 0; n < 2; ++n) buf[bj][n] = *(const f32x4*)(xbase + off_ + bj * 128 + n * 16); } while (0)
        RMS_LOADX(xa, 0); RMS_LOADX(xb, 1);
#pragma unroll
        for (int ai = 0; ai < 2; ++ai)
#pragma unroll
            for (int m = 0; m < 4; ++m) { float s = 0.f;
#pragma unroll
                for (int bj = 0; bj < 2; ++bj)
#pragma unroll
                    for (int n = 0; n < 2; ++n) { const f32x4 x = acc[ai][bj][m][n]; s += (x[0] * x[0] + x[1] * x[1]) + (x[2] * x[2] + x[3] * x[3]); }
                s += __shfl_xor(s, 16); s += __shfl_xor(s, 32);
                if (fq == 0) P[(ai * 128 + wr * 64 + m * 16 + fr) * 4 + wc] = s; }
        asm volatile("s_waitcnt lgkmcnt(0)" ::: "memory"); __builtin_amdgcn_s_barrier(); asm volatile("" ::: "memory");
        if (wid < 4) { const f32x4 p4 = *(const LAS f32x4*)(P + tid * 4); const float rs = (p4.x + p4.y) + (p4.z + p4.w);
            __hip_atomic_store((unsigned*)xbuf + (size_t)(prow0 + tid) * 4 + u.pn, __float_as_uint(rs), __ATOMIC_RELAXED, __HIP_MEMORY_SCOPE_AGENT);
            asm volatile("s_waitcnt vmcnt(0)" ::: "memory");
            if (lane == 0) __hip_atomic_fetch_add(cnt + 64 * u.pm, 1u, __ATOMIC_RELAXED, __HIP_MEMORY_SCOPE_AGENT); }
        if (wid == 0) { unsigned spins = 0;
            while ((unsigned)__builtin_amdgcn_readfirstlane(__hip_atomic_load(cnt + 64 * u.pm, __ATOMIC_RELAXED, __HIP_MEMORY_SCOPE_AGENT)) < 16u) { __builtin_amdgcn_s_sleep(2); if (++spins > (1u << 22)) break; }
            __builtin_amdgcn_fence(__ATOMIC_ACQUIRE, "agent");
            if (lane == 0) flag[0] = spins; }
        asm volatile("s_waitcnt vmcnt(0) lgkmcnt(0)" ::: "memory"); __builtin_amdgcn_s_barrier(); asm volatile("" ::: "memory");
        if (wid < 4) { const unsigned* slot = (const unsigned*)xbuf + (size_t)(prow0 + tid) * 4; float tot = 0.f;
#pragma unroll
            for (int t = 0; t < 4; ++t) tot += __uint_as_float(__hip_atomic_load(slot + t, __ATOMIC_RELAXED, __HIP_MEMORY_SCOPE_AGENT));
            S[tid] = __builtin_amdgcn_rsqf(tot * (1.0f / DM) + EPS); }
        asm volatile("s_waitcnt vmcnt(0) lgkmcnt(0)" ::: "memory"); __builtin_amdgcn_s_barrier(); asm volatile("" ::: "memory");
        f32x4 gp[2][2];
#pragma unroll
        for (int bj = 0; bj < 2; ++bj)
#pragma unroll
            for (int n = 0; n < 2; ++n) gp[bj][n] = *(const f32x4*)(gpost + col0 + bj * 128 + n * 16);
        float* obase = out + (size_t)prow0 * DM;
#define RMS_STORE(buf, grp) do { const int ai_ = (grp) >> 2, m_ = (grp) & 3; const int r_ = ai_ * 128 + wr * 64 + m_ * 16 + fr; const float rinv_ = S[r_]; const size_t off_ = (size_t)r_ * DM + col0; \
            _Pragma("unroll") for (int bj = 0; bj < 2; ++bj) _Pragma("unroll") for (int n = 0; n < 2; ++n) *(f32x4*)(obase + off_ + bj * 128 + n * 16) = buf[bj][n] + acc[ai_][bj][m_][n] * rinv_ * gp[bj][n]; } while (0)
#define SB __builtin_amdgcn_sched_barrier(0)
        RMS_STORE(xa, 0); SB; RMS_LOADX(xa, 2); SB; RMS_STORE(xb, 1); SB; RMS_LOADX(xb, 3); SB;
        RMS_STORE(xa, 2); SB; RMS_LOADX(xa, 4); SB; RMS_STORE(xb, 3); SB; RMS_LOADX(xb, 5); SB;
        RMS_STORE(xa, 4); SB; RMS_LOADX(xa, 6); SB; RMS_STORE(xb, 5); SB; RMS_LOADX(xb, 7); SB;
        RMS_STORE(xa, 6); SB; RMS_STORE(xb, 7);
#undef SB
#undef RMS_LOADX
#undef RMS_STORE
    }
};

struct Args { const float* in[13]; float* out; unsigned char* ws; int ph_lo, ph_hi; };
struct Frame {
    LAS unsigned char* lds;
    int tid, lane, wave, G;
};
#define A_XP(a) ((a).in[0])
#define A_XS(a) ((a).in[1])
#define A_SPOOL(a) ((a).in[2])
#define A_SGLA(a) ((a).in[3])
#define A_GPRE(a) ((a).in[4])
#define A_WIN(a) ((a).in[5])
#define A_WGU(a) ((a).in[6])
#define A_BGU(a) ((a).in[7])
#define A_WPOOL(a) ((a).in[8])
#define A_PSCALE(a) ((a).in[9])
#define A_GGO(a) ((a).in[10])
#define A_WOUT(a) ((a).in[11])
#define A_GPOST(a) ((a).in[12])
#define A_WINT(a) ((bf16*)((a).ws + WS_WIN))
#define A_WOUTT(a) ((bf16*)((a).ws + WS_WOUT))
#define A_WPT(a) ((bf16*)((a).ws + WS_WP))
#define A_XN(a) ((bf16*)((a).ws + WS_XN))
#define A_Z(a) ((bf16*)((a).ws + WS_Z))
#define A_PART(a) ((float*)((a).ws + WS_PART))
__device__ __forceinline__ float wave_sum(float v) {
#pragma unroll
    for (int o = 1; o < 64; o <<= 1) v += __shfl_xor(v, o);
    return v;
}
__device__ __forceinline__ const float* xrow(const Args& A, int m) { return m < MP ? A_XP(A) + (size_t)m * DM : A_XS(A) + (size_t)(m - MP) * DM; }

__device__ __forceinline__ void p0_transpose_item(const float* W, int K, int N, bf16* WT, int dstrow0, int nsrc0, int nvalid, int k0, LAS float* scr, int lane) {
    { f32x4 v[8]; const int n4 = (lane & 7) * 4;
#pragma unroll
      for (int i = 0; i < 8; ++i) { const int kk = 8 * i + (lane >> 3); v[i] = (n4 < nvalid) ? *(const f32x4*)(W + (size_t)(k0 + kk) * N + nsrc0 + n4) : (f32x4){0.f, 0.f, 0.f, 0.f}; }
#pragma unroll
      for (int i = 0; i < 8; ++i) { const int kk = 8 * i + (lane >> 3); LAS float* d = scr + kk * 33 + n4; d[0] = v[i].x; d[1] = v[i].y; d[2] = v[i].z; d[3] = v[i].w; } }
    LDS_WAIT(); asm volatile("" ::: "memory");
    const int c = lane & 7;
#pragma unroll
    for (int j = 0; j < 4; ++j) { const int n = (lane >> 3) + 8 * j; const LAS float* s = scr + (8 * c) * 33 + n;
        v4u o; o.x = pk2(s[0 * 33], s[1 * 33]); o.y = pk2(s[2 * 33], s[3 * 33]); o.z = pk2(s[4 * 33], s[5 * 33]); o.w = pk2(s[6 * 33], s[7 * 33]);
        *(GAS v4u*)(WT + (size_t)(dstrow0 + n) * K + k0 + 8 * c) = o; }
    LDS_WAIT(); asm volatile("" ::: "memory");
}
__device__ __forceinline__ void p0_prologue(Frame& F, const Args& A) {
    LAS float* scr = (LAS float*)(F.lds + F.wave * 16384);
    const int gw = blockIdx.x * NWAVES + F.wave, NGW = F.G * NWAVES;
    constexpr int I_IN = (1024 / 64) * (NINP / 32), I_OUT = (2048 / 64) * (1024 / 32), I_P = 4 * (256 / 64) * (256 / 32);
    f32x4 gp[4];
#pragma unroll
    for (int j = 0; j < 4; ++j) gp[j] = *((const f32x4*)A_GPRE(A) + F.lane + 64 * j);
    f32x4 c0[4], c1[4], n0[4], n1[4];
#define XN_LOAD(d0, d1, mm) do { const int m1_ = (mm) + NGW; const GAS f32x4* p0_ = (const GAS f32x4*)xrow(A, (mm) < M ? (mm) : gw) + F.lane; const GAS f32x4* p1_ = (const GAS f32x4*)xrow(A, m1_ < M ? m1_ : gw) + F.lane; \
        _Pragma("unroll") for (int j = 0; j < 4; ++j) d0[j] = p0_[64 * j]; _Pragma("unroll") for (int j = 0; j < 4; ++j) d1[j] = p1_[64 * j]; } while (0)
    XN_LOAD(c0, c1, gw);
    for (int it = gw; it < I_IN + I_OUT + I_P; it += NGW) {
        int r = it;
        if (r < I_IN) { const int nblk = NINP / 32, kb = r / nblk, nb = r % nblk, n0 = 32 * nb;
            int src = n0, nvalid = 32;
            if (n0 >= 1024 && n0 < 3072) src = n0 + 1024; else if (n0 >= 3072 && n0 < 4096) src = n0 - 2048;
            if (n0 == 5120) nvalid = 16; else if (n0 > 5120) { nvalid = 0; src = 0; }
            p0_transpose_item(A_WIN(A), 1024, NIN, A_WINT(A), n0, src, nvalid, 64 * kb, scr, F.lane); continue; }
        r -= I_IN;
        if (r < I_OUT) { const int nblk = 1024 / 32, kb = r / nblk, nb = r % nblk; p0_transpose_item(A_WOUT(A), 2048, 1024, A_WOUTT(A), 32 * nb, 32 * nb, 32, 64 * kb, scr, F.lane); continue; }
        r -= I_OUT;
        { const int gq = r / 32, rr = r % 32, kb = rr / 8, nb = rr % 8; p0_transpose_item(A_WPOOL(A) + (size_t)gq * 65536, 256, 256, A_WPT(A), gq * 256 + 32 * nb, 32 * nb, 32, 64 * kb, scr, F.lane); }
    }
    for (int m = gw; m < M; m += 2 * NGW) {
        const int m1 = m + NGW; const bool two = m1 < M;
        XN_LOAD(n0, n1, m + 2 * NGW);
        float s0 = 0.f, s1 = 0.f;
#pragma unroll
        for (int j = 0; j < 4; ++j) { s0 += (c0[j].x * c0[j].x + c0[j].y * c0[j].y) + (c0[j].z * c0[j].z + c0[j].w * c0[j].w); s1 += (c1[j].x * c1[j].x + c1[j].y * c1[j].y) + (c1[j].z * c1[j].z + c1[j].w * c1[j].w); }
        const float r0 = 1.0f / sqrtf(wave_sum(s0) * (1.f / DM) + EPS), r1 = 1.0f / sqrtf(wave_sum(s1) * (1.f / DM) + EPS);
        GAS unsigned long long* o0 = (GAS unsigned long long*)(A_XN(A) + (size_t)m * DM) + F.lane;
#pragma unroll
        for (int j = 0; j < 4; ++j) o0[64 * j] = (unsigned long long)pk2(c0[j].x * r0 * gp[j].x, c0[j].y * r0 * gp[j].y) | ((unsigned long long)pk2(c0[j].z * r0 * gp[j].z, c0[j].w * r0 * gp[j].w) << 32);
        if (two) { GAS unsigned long long* o1 = (GAS unsigned long long*)(A_XN(A) + (size_t)m1 * DM) + F.lane;
#pragma unroll
            for (int j = 0; j < 4; ++j) o1[64 * j] = (unsigned long long)pk2(c1[j].x * r1 * gp[j].x, c1[j].y * r1 * gp[j].y) | ((unsigned long long)pk2(c1[j].z * r1 * gp[j].z, c1[j].w * r1 * gp[j].w) << 32); }
#pragma unroll
        for (int j = 0; j < 4; ++j) { c0[j] = n0[j]; c1[j] = n1[j]; }
    }
#undef XN_LOAD
}

template <int w, int MODE>
__device__ __forceinline__ void poolgen_half(const LAS unsigned char* srow, const float* hist, LAS unsigned char* dA, LAS unsigned char* dB) {
#pragma unroll
    for (int sb = 0; sb < 2; ++sb) {
        unsigned outlo[8];
#pragma unroll
        for (int ep = 0; ep < 2; ++ep) {
            float a[23][2];
#pragma unroll
            for (int i = 0; i < 23; ++i) {
                if (i < 16 - w || (MODE == 1 && 8 * sb + i < 15)) { a[i][0] = 0.f; a[i][1] = 0.f; }
                else if (MODE == 2 && 8 * sb + i < 15) { const f32x2v hv = *(const f32x2v*)(hist + (8 * sb + i) * 1024 + 2 * ep); a[i][0] = hv.x; a[i][1] = hv.y; }
                else { const unsigned wv = *(const LAS unsigned*)(srow + (8 * sb + i) * 512 + 4 * ep); a[i][0] = bflo(wv); a[i][1] = bfhi(wv); } }
            float cur[8][2];
#pragma unroll
            for (int r = 0; r < 8; ++r) { cur[r][0] = a[15 + r][0]; cur[r][1] = a[15 + r][1]; }
#pragma unroll
            for (int i = 22; i >= 1; --i) { a[i][0] += a[i - 1][0]; a[i][1] += a[i - 1][1]; }
            if (w >= 4) {
#pragma unroll
                for (int i = 22; i >= 3; --i) { a[i][0] += a[i - 2][0]; a[i][1] += a[i - 2][1]; } }
            if (w >= 8) {
#pragma unroll
                for (int i = 22; i >= 7; --i) { a[i][0] += a[i - 4][0]; a[i][1] += a[i - 4][1]; } }
            if (w >= 16) {
#pragma unroll
                for (int i = 22; i >= 15; --i) { a[i][0] += a[i - 8][0]; a[i][1] += a[i - 8][1]; } }
#pragma unroll
            for (int r = 0; r < 8; ++r) { const float rc = 1.0f / (float)((MODE == 1 && 8 * sb + r + 1 < w) ? 8 * sb + r + 1 : w);
                const unsigned o = pg8::cvt_pk_bf16(a[15 + r][0] * rc - cur[r][0], a[15 + r][1] * rc - cur[r][1]);
                if (ep == 0) outlo[r] = o; else *(LAS v2u*)((sb ? dB : dA) + r * 64) = (v2u){outlo[r], o}; }
            __builtin_amdgcn_sched_barrier(0);
        }
    }
}
#define OPQ(x) asm volatile("" : "+v"(x))
__device__ __forceinline__ void pool_unit_of(int V, int& R0, int& g) { if (V < 1024) { g = V >> 8; R0 = ((V & 255) >> 1) * 256 + (V & 1) * 128; } else { const int s_ = V - 1024; g = (s_ >> 1) & 3; R0 = (128 + (s_ >> 3)) * 256 + (s_ & 1) * 128; } }
__device__ __forceinline__ void pool_run(Frame& F, const Args& A, int ubeg, int uend) {
    LAS unsigned char* lds = F.lds;
    const int wid = F.wave;
    if (ubeg >= uend) return;
    int R0, g; pool_unit_of(ubeg, R0, g);
    int gB = -1;
#define PU_DMA(R0x, gx) do { int ln_ = F.lane; OPQ(ln_); const char* zb_ = (const char*)A_Z(A) + ((long)((R0x) - 16 + 18 * wid) * LDZ + ZU + (gx) * 256) * 2; \
        const unsigned vo_ = (unsigned)((ln_ >> 5) * (LDZ * 2) + (ln_ & 31) * 16); \
        _Pragma("unroll") for (int q = 0; q < 9; ++q) __builtin_amdgcn_global_load_lds((const unsigned*)(zb_ + vo_ + q * (4 * LDZ)), (LAS unsigned*)(lds + PU_STG + (wid * 9 + q) * 1024), 16, 0, 0); } while (0)
    PU_DMA(R0, g);
    pg8::bf16x8 Bf[2][8];
    for (int nu = 0;; ++nu) {
        int R0n = R0, gn = g; const int un = ubeg + nu + 1; const bool hasn = un < uend; if (hasn) pool_unit_of(un, R0n, gn);
        asm volatile("s_waitcnt vmcnt(0)" ::: "memory"); __syncthreads();
        int lane = F.lane; OPQ(lane);
        const int fr = lane & 15, fq = lane >> 4;
        bf16* base = A_Z(A) + (size_t)(R0 + fr) * LDZ + ZGP + g * 256 + wid * 32 + 8 * fq;
        v4u gs[8];
#pragma unroll
        for (int m = 0; m < 8; ++m) gs[m] = *(const v4u*)(base + (size_t)(16 * m) * LDZ);
        const bf16* wb = A_WPT(A) + (size_t)(g * 256 + wid * 32 + 8 * (fr >> 2) + (fr & 3)) * 256 + 8 * fq;
        if (g != gB) { gB = g;
#pragma unroll
            for (int n = 0; n < 2; ++n)
#pragma unroll
                for (int kk = 0; kk < 8; ++kk) Bf[n][kk] = *(const pg8::bf16x8*)(wb + (4 * n) * 256 + 32 * kk); }
        __builtin_amdgcn_sched_barrier(0);
        { int ln = F.lane; OPQ(ln);
          const int row0 = R0 + wid * 16; const bool samp = row0 >= MP;
          int b, ts; if (!samp) { b = row0 / TP; ts = row0 % TP; } else { b = (row0 - MP) / TS; ts = (row0 - MP) % TS; }
          const int w = 2 << g, c0 = g * 256 + 4 * ln;
          LAS unsigned char* dA = lds + (ln >> 4) * 16384 + (wid * 2 + ((ln >> 3) & 1)) * 1024 + 8 * (ln & 7);
          LAS unsigned char* dB = lds + (ln >> 4) * 16384 + (wid * 2 + ((ln >> 3) & 1)) * 1024 + 512 + ((8 * (ln & 7)) ^ 32);
          const LAS unsigned char* srow = lds + PU_STG + (16 * wid + 1) * 512 + 8 * ln;
          const float* hist = A_SPOOL(A) + (size_t)b * 15 * 1024 + c0;
          const int mode = ts >= 15 ? 0 : (samp ? 2 : 1);
#define PU_GEN(W) do { if (mode == 0) poolgen_half<W, 0>(srow, hist, dA, dB); else if (mode == 1) poolgen_half<W, 1>(srow, hist, dA, dB); else poolgen_half<W, 2>(srow, hist, dA, dB); } while (0)
          if (w == 2) PU_GEN(2); else if (w == 4) PU_GEN(4); else if (w == 8) PU_GEN(8); else PU_GEN(16);
#undef PU_GEN
        }
        __builtin_amdgcn_sched_barrier(0);
#pragma unroll
        for (int m = 0; m < 8; ++m) asm volatile("" : "+v"(gs[m]));
#pragma unroll
        for (int n = 0; n < 2; ++n)
#pragma unroll
            for (int kk = 0; kk < 8; ++kk) asm volatile("" : "+v"(Bf[n][kk]));
        f32x4 acc[8][2];
#pragma unroll
        for (int m = 0; m < 8; ++m)
#pragma unroll
            for (int n = 0; n < 2; ++n) acc[m][n] = (f32x4){0.f, 0.f, 0.f, 0.f};
        LDS_WAIT(); asm volatile("" ::: "memory");
        __builtin_amdgcn_s_barrier();
        asm volatile("" ::: "memory");
        PU_DMA(R0n, gn);
        __builtin_amdgcn_sched_barrier(0);
        const int aoff = pg8::lds_byte(fr, fq * 8);
#pragma unroll
        for (int t = 0; t < 4; ++t)
#pragma unroll
            for (int mh = 0; mh < 2; ++mh) {
                pg8::bf16x8 At[4][2];
#pragma unroll
                for (int m = 0; m < 4; ++m)
#pragma unroll
                    for (int kk = 0; kk < 2; ++kk) At[m][kk] = *(const LAS pg8::bf16x8*)(lds + t * 16384 + aoff + (4 * mh + m) * 2048 + kk * 1024);
#pragma unroll
                for (int m = 0; m < 4; ++m)
#pragma unroll
                    for (int n = 0; n < 2; ++n)
#pragma unroll
                        for (int kk = 0; kk < 2; ++kk) acc[4 * mh + m][n] = __builtin_amdgcn_mfma_f32_16x16x32_bf16(Bf[n][2 * t + kk], At[m][kk], acc[4 * mh + m][n], 0, 0, 0);
            }
#pragma unroll
        for (int m = 0; m < 8; ++m) { const v4u gsg = gs[m];
            const f32x4 v0 = acc[m][0] * (f32x4){bflo(gsg.x), bfhi(gsg.x), bflo(gsg.y), bfhi(gsg.y)}, v1 = acc[m][1] * (f32x4){bflo(gsg.z), bfhi(gsg.z), bflo(gsg.w), bfhi(gsg.w)};
            v4u o; o.x = pg8::cvt_pk_bf16(v0[0], v0[1]); o.y = pg8::cvt_pk_bf16(v0[2], v0[3]); o.z = pg8::cvt_pk_bf16(v1[0], v1[1]); o.w = pg8::cvt_pk_bf16(v1[2], v1[3]);
            *(v4u*)(base + (size_t)(16 * m) * LDZ) = o; }
        if (!hasn) break;
        R0 = R0n; g = gn;
    }
#undef PU_DMA
    asm volatile("s_waitcnt vmcnt(0)" ::: "memory"); __syncthreads();
}
__device__ __forceinline__ void newpool_copy(Frame& F, const Args& A) {
    const int gw = blockIdx.x * NWAVES + F.wave, NGW = F.G * NWAVES;
    for (int r = gw; r < 32 * 15; r += NGW) { const int s = r / 15, i = r % 15;
        const int src = s < 16 ? s * TP + (TP - 15) + i : MP + (s - 16) * TS + (TS - 15) + i;
        float* dst = A.out + (s < 16 ? O_NPP + (size_t)(s * 15 + i) * 1024 : O_NPS + (size_t)((s - 16) * 15 + i) * 1024);
        const bf16* sp = A_Z(A) + (size_t)src * LDZ + ZU;
#pragma unroll
        for (int j = 0; j < 2; ++j) { const int c = 8 * F.lane + 512 * j; const v4u w4 = *(const v4u*)(sp + c);
            *(f32x4*)(dst + c) = (f32x4){bflo(w4.x), bfhi(w4.x), bflo(w4.y), bfhi(w4.y)}; *(f32x4*)(dst + c + 4) = (f32x4){bflo(w4.z), bfhi(w4.z), bflo(w4.w), bfhi(w4.w)}; }
    }
}

constexpr int GL_GLRB = 0, GL_WGT = 2048, GL_BIAS = 6144, GL_GTOT = 6656, GL_DEXP = 7680, GL_PART = 8192, GL_GG = 10240, GL_QT = 11264, GL_KT = 28672, GL_OI = GL_QT, GL_VT = 46080, GL_VR = 82944, GL_KDT = GL_VR, GL_PP = GL_VR + 18432, GL_END = GL_VR + 33792;
static_assert(GL_END <= 131072 && GL_PP + 9216 <= GL_END && GL_OI + 64 * 264 * 2 <= GL_VT, "GLA LDS map");
template <bool SO>
__device__ __forceinline__ void gla_unit(Frame& F, const Args& A, int row0, int nchunk, int h, int nprev, const float* sprev, const float* bprev, bool raws, float* Sout, float* Bout) {
    LAS unsigned char* lds = F.lds;
    LAS unsigned char* GLRB = lds + GL_GLRB; LAS unsigned char* WGT = lds + GL_WGT; LAS float* BIAS = (LAS float*)(lds + GL_BIAS); LAS float* GTOT = (LAS float*)(lds + GL_GTOT);
    LAS float* DEXP = (LAS float*)(lds + GL_DEXP); LAS float* PART = (LAS float*)(lds + GL_PART); LAS float* GG = (LAS float*)(lds + GL_GG);
    LAS unsigned char* QT = lds + GL_QT; LAS unsigned char* KT = lds + GL_KT; LAS unsigned char* OI = lds + GL_OI; LAS unsigned char* KDT = lds + GL_KDT; LAS unsigned char* VT = lds + GL_VT; LAS unsigned char* PP = lds + GL_PP; LAS unsigned char* VR = lds + GL_VR;
    const int wid = F.wave;
    const bf16* Z = A_Z(A);
    { const int tid = F.tid, k = tid & 127, r4 = tid >> 7; const float* wp = A_WGU(A) + (size_t)(4 * r4) * 512 + h * 128 + k;
      *(LAS v2u*)(WGT + (k * 16 + 4 * r4) * 2) = (v2u){pk2(wp[0], wp[512]), pk2(wp[1024], wp[1536])};
      if (tid < 128) BIAS[tid] = A_BGU(A)[h * 128 + tid];
      if (tid < 256) GG[tid] = A_GGO(A)[tid]; }
    f32x16 S[4];
#pragma unroll
    for (int kb = 0; kb < 4; ++kb)
#pragma unroll
        for (int r = 0; r < 16; ++r) S[kb][r] = 0.f;
    for (int p = 0; p < nprev; ++p) { int ln = F.lane; OPQ(ln); const int hh = ln >> 5, l31 = ln & 31; const float* sp = sprev + (size_t)p * 32768; const float* bp = bprev + (size_t)p * 128;
        if (raws) {
#pragma unroll
            for (int kb = 0; kb < 4; ++kb)
#pragma unroll
                for (int r = 0; r < 16; ++r) { const int k = 32 * kb + (r & 3) + 8 * (r >> 2) + 4 * hh; S[kb][r] = sp[(size_t)k * 256 + 32 * wid + l31]; }
        } else {
#pragma unroll
            for (int kb = 0; kb < 4; ++kb)
#pragma unroll
                for (int g = 0; g < 4; ++g) { const f32x4 sv = *(const f32x4*)(sp + (size_t)(((wid * 4 + kb) * 4 + g) * 64 + ln) * 4); const f32x4 bv = *(const f32x4*)(bp + 32 * kb + 8 * g + 4 * hh);
                    S[kb][4 * g + 0] = S[kb][4 * g + 0] * __expf(bv.x) + sv.x; S[kb][4 * g + 1] = S[kb][4 * g + 1] * __expf(bv.y) + sv.y; S[kb][4 * g + 2] = S[kb][4 * g + 2] * __expf(bv.z) + sv.z; S[kb][4 * g + 3] = S[kb][4 * g + 3] * __expf(bv.w) + sv.w; }
        } }
    float bsum = 0.f;
    v4u rq[2], rk[2], rv[4], rg;
#define GLA_LOAD_RAW(zbase) do { int t_ = F.tid; OPQ(t_); \
        _Pragma("unroll") for (int i = 0; i < 2; ++i) { const int idx = t_ + 512 * i, row = idx >> 4, c8 = idx & 15; const unsigned off = (unsigned)((row * LDZ + ZQ + h * 128 + 8 * c8) * 2); if constexpr (!SO) rq[i] = *(const v4u*)((zbase) + off); rk[i] = *(const v4u*)((zbase) + off + (ZK - ZQ) * 2); } \
        _Pragma("unroll") for (int i = 0; i < 4; ++i) { const int idx = t_ + 512 * i, row = idx >> 5, c8 = idx & 31; rv[i] = *(const v4u*)((zbase) + (unsigned)((row * LDZ + ZV + h * 256 + 8 * c8) * 2)); } \
        if (t_ < 128) rg = *(const v4u*)((zbase) + (unsigned)(((t_ >> 1) * LDZ + ZLR + 8 * (t_ & 1)) * 2)); } while (0)
#define GLA_LOAD_QK(zbase) do { int t_ = F.tid; OPQ(t_); \
        _Pragma("unroll") for (int i = 0; i < 2; ++i) { const int idx = t_ + 512 * i, row = idx >> 4, c8 = idx & 15; const unsigned off = (unsigned)((row * LDZ + ZQ + h * 128 + 8 * c8) * 2); if constexpr (!SO) rq[i] = *(const v4u*)((zbase) + off); rk[i] = *(const v4u*)((zbase) + off + (ZK - ZQ) * 2); } \
        if (t_ < 128) rg = *(const v4u*)((zbase) + (unsigned)(((t_ >> 1) * LDZ + ZLR + 8 * (t_ & 1)) * 2)); } while (0)
#define GLA_LD_K(i, zbase) do { int t_ = F.tid; OPQ(t_); const int idx = t_ + 512 * (i), row = idx >> 4, c8 = idx & 15; __builtin_amdgcn_sched_barrier(0); rk[i] = *(const v4u*)((zbase) + (unsigned)((row * LDZ + ZK + h * 128 + 8 * c8) * 2)); __builtin_amdgcn_sched_barrier(0); } while (0)
#define GLA_LD_Q(i, zbase) do { int t_ = F.tid; OPQ(t_); const int idx = t_ + 512 * (i), row = idx >> 4, c8 = idx & 15; __builtin_amdgcn_sched_barrier(0); rq[i] = *(const v4u*)((zbase) + (unsigned)((row * LDZ + ZQ + h * 128 + 8 * c8) * 2)); __builtin_amdgcn_sched_barrier(0); } while (0)
#define GLA_LD_G(zbase) do { int t_ = F.tid; OPQ(t_); __builtin_amdgcn_sched_barrier(0); if (t_ < 128) rg = *(const v4u*)((zbase) + (unsigned)(((t_ >> 1) * LDZ + ZLR + 8 * (t_ & 1)) * 2)); __builtin_amdgcn_sched_barrier(0); } while (0)
#define GLA_LD_V(i, zbase) do { int t_ = F.tid; OPQ(t_); const int idx = t_ + 512 * (i), row = idx >> 5, c8 = idx & 31; __builtin_amdgcn_sched_barrier(0); rv[i] = *(const v4u*)((zbase) + (unsigned)((row * LDZ + ZV + h * 256 + 8 * c8) * 2)); __builtin_amdgcn_sched_barrier(0); } while (0)
#define GLA_LD_S(n, zbase) do { int t_ = F.tid; OPQ(t_); const int idx = t_ + 512 * (n), row = idx >> 5, c8 = idx & 31; __builtin_amdgcn_sched_barrier(0); sgv[n] = *(const v4u*)((zbase) + (unsigned)((row * LDZ + ZGG + h * 256 + 8 * c8) * 2)); __builtin_amdgcn_sched_barrier(0); } while (0)
#define GLA_LOAD_V(zbase) do { int t_ = F.tid; OPQ(t_); \
        _Pragma("unroll") for (int i = 0; i < 4; ++i) { const int idx = t_ + 512 * i, row = idx >> 5, c8 = idx & 31; rv[i] = *(const v4u*)((zbase) + (unsigned)((row * LDZ + ZV + h * 256 + 8 * c8) * 2)); } } while (0)
    { const char* z0 = (const char*)Z + (size_t)row0 * (LDZ * 2); GLA_LOAD_RAW(z0); }
    __syncthreads();

    for (int c = 0; c < nchunk; ++c) {
        const char* zc = (const char*)Z + (size_t)(row0 + 64 * c) * (LDZ * 2);
        { int tid = F.tid; OPQ(tid);
#pragma unroll
          for (int i = 0; i < 2; ++i) { const int idx = tid + 512 * i, row = idx >> 4, c8 = idx & 15; if constexpr (!SO) *(LAS v4u*)(QT + (row * 136 + 8 * c8) * 2) = rq[i]; *(LAS v4u*)(KT + (row * 136 + 8 * c8) * 2) = rk[i]; }
#pragma unroll
          for (int i = 0; i < 4; ++i) { const int idx = tid + 512 * i, row = idx >> 5, c8 = idx & 31; *(LAS v4u*)(VR + (row * 264 + 8 * c8) * 2) = rv[i]; }
          if (tid < 128) *(LAS v4u*)(GLRB + tid * 16) = rg; }
        __syncthreads();
        const bool nx = c + 1 < nchunk; const char* zn = zc + (size_t)64 * (LDZ * 2);
        if (nx) GLA_LD_G(zn);
        v4u sgv[4];
        { int tid = F.tid; OPQ(tid); const int vv = tid & 255, jh = tid >> 8;
#pragma unroll
          for (int q = 0; q < 4; ++q) { unsigned e[8];
#pragma unroll
              for (int x = 0; x < 8; ++x) e[x] = *(const LAS unsigned short*)(VR + ((32 * jh + 8 * q + x) * 264 + vv) * 2);
              *(LAS v4u*)(VT + (vv * 72 + 32 * jh + 8 * q) * 2) = (v4u){e[0] | (e[1] << 16), e[2] | (e[3] << 16), e[4] | (e[5] << 16), e[6] | (e[7] << 16)}; } }
        float pb[16];
        { int lane = F.lane; OPQ(lane); const int hh = lane >> 5, l31 = lane & 31; const int kb = wid & 3, jb = wid >> 2, k = 32 * kb + l31;
          const bf16x8 ga = *(const LAS bf16x8*)(GLRB + ((32 * jb + l31) * 16 + 8 * hh) * 2);
          const bf16x8 wb = *(const LAS bf16x8*)(WGT + (k * 16 + 8 * hh) * 2);
          f32x16 d;
#pragma unroll
          for (int r = 0; r < 16; ++r) d[r] = 0.f;
          d = __builtin_amdgcn_mfma_f32_32x32x16_bf16(ga, wb, d, 0, 0, 0);
          const float bias = BIAS[k];
          float gs[4], pgs[4];
#pragma unroll
          for (int g = 0; g < 4; ++g) { float run = 0.f;
              if (nx) { if (g == 0) GLA_LD_K(0, zn); else if (g == 1) GLA_LD_K(1, zn); else if constexpr (!SO) { if (g == 2) GLA_LD_Q(0, zn); else GLA_LD_Q(1, zn); } }
#pragma unroll
              for (int e = 0; e < 4; ++e) { const float a = d[4 * g + e] + bias; const float la = (fminf(a, 0.f) - __logf(1.0f + __expf(-fabsf(a)))) * (1.0f / 16.0f); run += la; pb[4 * g + e] = run; }
              gs[g] = run; }
#pragma unroll
          for (int g = 0; g < 4; ++g) pgs[g] = __shfl_xor(gs[g], 32);
          float offs = 0.f;
#pragma unroll
          for (int g = 0; g < 4; ++g) { const float mine = offs + (hh ? pgs[g] : 0.f);
#pragma unroll
              for (int e = 0; e < 4; ++e) pb[4 * g + e] += mine;
              offs += gs[g] + pgs[g]; }
          if (hh == 0) GTOT[jb * 128 + k] = offs; }
        __syncthreads();
        { int lane = F.lane; OPQ(lane); const int hh = lane >> 5, l31 = lane & 31; const int kb = wid & 3, jb = wid >> 2, k = 32 * kb + l31;
          const float t0 = GTOT[k], t1 = GTOT[128 + k]; const float bend = t0 + t1, joff = jb ? t0 : 0.f; const float ebend = __expf(bend);
          bsum += bend;
#pragma unroll
          for (int g = 0; g < 4; ++g) { float kdv[4];
              if (nx) { if (g == 0) GLA_LD_V(0, zn); else if (g == 1) GLA_LD_V(1, zn); else if (g == 2) GLA_LD_V(2, zn); else GLA_LD_V(3, zn); }
#pragma unroll
              for (int e = 0; e < 4; ++e) { const int j = 32 * jb + 8 * g + 4 * hh + e; const float b = pb[4 * g + e] + joff;
                  LAS unsigned short* kp = (LAS unsigned short*)(KT + (j * 136 + k) * 2); const float kk = bf2f(*kp);
                  if constexpr (!SO) { LAS unsigned short* qp = (LAS unsigned short*)(QT + (j * 136 + k) * 2); const float q = bf2f(*qp);
                      const float qt = q * __expf(b), kt = kk * __expf(-b); kdv[e] = kt * ebend;
                      const unsigned w = pg8::cvt_pk_bf16(qt, kt); *qp = (unsigned short)w; *kp = (unsigned short)(w >> 16); }
                  else kdv[e] = kk * __expf(bend - b); }
              *(LAS v2u*)(KDT + (k * 72 + 32 * jb + 8 * g + 4 * hh) * 2) = (v2u){pg8::cvt_pk_bf16(kdv[0], kdv[1]), pg8::cvt_pk_bf16(kdv[2], kdv[3])}; }
          if (jb == 0 && hh == 0) DEXP[k] = ebend; }
        __syncthreads();
        f32x16 o[2];
        if constexpr (!SO) {
        if (wid < 3) { int lane = F.lane; OPQ(lane); const int hh = lane >> 5, l31 = lane & 31;
            const int jb = (wid == 2) ? 1 : 0, ib = (wid >= 1) ? 1 : 0;
            f32x16 sc;
#pragma unroll
            for (int r = 0; r < 16; ++r) sc[r] = 0.f;
#pragma unroll
            for (int s = 0; s < 8; ++s) { const bf16x8 a = *(const LAS bf16x8*)(KT + ((32 * jb + l31) * 136 + 16 * s + 8 * hh) * 2); const bf16x8 bq = *(const LAS bf16x8*)(QT + ((32 * ib + l31) * 136 + 16 * s + 8 * hh) * 2);
                sc = __builtin_amdgcn_mfma_f32_32x32x16_bf16(a, bq, sc, 0, 0, 0); }
            const int i = 32 * ib + l31;
#pragma unroll
            for (int g = 0; g < 4; ++g) { const int j0 = 32 * jb + 8 * g + 4 * hh; float v[4];
#pragma unroll
                for (int e = 0; e < 4; ++e) v[e] = (i >= j0 + e) ? sc[4 * g + e] : 0.f;
                *(LAS v2u*)(PP + (i * 72 + j0) * 2) = (v2u){pg8::cvt_pk_bf16(v[0], v[1]), pg8::cvt_pk_bf16(v[2], v[3])}; } }
        { int lane = F.lane; OPQ(lane); const int hh = lane >> 5, l31 = lane & 31;
#pragma unroll
          for (int ib = 0; ib < 2; ++ib)
#pragma unroll
            for (int r = 0; r < 16; ++r) o[ib][r] = 0.f;
#pragma unroll
          for (int kb = 0; kb < 4; ++kb) {
            if (kb == 0) GLA_LD_S(0, zc); else if (kb == 1) GLA_LD_S(1, zc); else if (kb == 2) GLA_LD_S(2, zc); else GLA_LD_S(3, zc);
#pragma unroll
            for (int s = 0; s < 2; ++s) {
                v4u af; af.x = pg8::cvt_pk_bf16(S[kb][8 * s + 0], S[kb][8 * s + 1]); af.y = pg8::cvt_pk_bf16(S[kb][8 * s + 2], S[kb][8 * s + 3]); af.z = pg8::cvt_pk_bf16(S[kb][8 * s + 4], S[kb][8 * s + 5]); af.w = pg8::cvt_pk_bf16(S[kb][8 * s + 6], S[kb][8 * s + 7]);
                const bf16x8 a = __builtin_bit_cast(bf16x8, af);
#pragma unroll
                for (int ib = 0; ib < 2; ++ib) { const LAS unsigned char* qp = QT + ((32 * ib + l31) * 136 + 32 * kb + 16 * s + 4 * hh) * 2;
                    const v2u lo = *(const LAS v2u*)qp, hi = *(const LAS v2u*)(qp + 16);
                    const bf16x8 bq = __builtin_bit_cast(bf16x8, ((v4u){lo.x, lo.y, hi.x, hi.y}));
                    o[ib] = __builtin_amdgcn_mfma_f32_32x32x16_bf16(a, bq, o[ib], 0, 0, 0); } } } }
        __syncthreads();
        { int lane = F.lane; OPQ(lane); const int hh = lane >> 5, l31 = lane & 31;
#pragma unroll
          for (int s = 0; s < 4; ++s) { const bf16x8 a = *(const LAS bf16x8*)(VT + ((32 * wid + l31) * 72 + 16 * s + 8 * hh) * 2);
            if (s < 2) { const bf16x8 b0 = *(const LAS bf16x8*)(PP + (l31 * 72 + 16 * s + 8 * hh) * 2); o[0] = __builtin_amdgcn_mfma_f32_32x32x16_bf16(a, b0, o[0], 0, 0, 0); }
            const bf16x8 b1 = *(const LAS bf16x8*)(PP + ((32 + l31) * 72 + 16 * s + 8 * hh) * 2); o[1] = __builtin_amdgcn_mfma_f32_32x32x16_bf16(a, b1, o[1], 0, 0, 0); }
#pragma unroll
          for (int ib = 0; ib < 2; ++ib) { float ss = 0.f;
#pragma unroll
            for (int r = 0; r < 16; ++r) ss += o[ib][r] * o[ib][r];
            ss += __shfl_xor(ss, 32);
            if (hh == 0) PART[wid * 64 + 32 * ib + l31] = ss; } }
        }
        { int lane = F.lane; OPQ(lane); const int hh = lane >> 5, l31 = lane & 31;
#pragma unroll
          for (int kb = 0; kb < 4; ++kb) {
#pragma unroll
            for (int g = 0; g < 4; ++g) { const f32x4 d4 = *(const LAS f32x4*)(DEXP + 32 * kb + 8 * g + 4 * hh);
                S[kb][4 * g + 0] *= d4.x; S[kb][4 * g + 1] *= d4.y; S[kb][4 * g + 2] *= d4.z; S[kb][4 * g + 3] *= d4.w; }
#pragma unroll
            for (int s = 0; s < 4; ++s) { const bf16x8 a = *(const LAS bf16x8*)(KDT + ((32 * kb + l31) * 72 + 16 * s + 8 * hh) * 2); const bf16x8 bv = *(const LAS bf16x8*)(VT + ((32 * wid + l31) * 72 + 16 * s + 8 * hh) * 2);
                S[kb] = __builtin_amdgcn_mfma_f32_32x32x16_bf16(a, bv, S[kb], 0, 0, 0); } } }
        if constexpr (!SO) {
        __syncthreads();
        { int lane = F.lane; OPQ(lane); const int hh = lane >> 5, l31 = lane & 31;
#pragma unroll
          for (int ib = 0; ib < 2; ++ib) { float tot = 0.f;
#pragma unroll
            for (int w8 = 0; w8 < 8; ++w8) tot += PART[w8 * 64 + 32 * ib + l31];
            const float rinv = __builtin_amdgcn_rsqf(tot * (1.0f / 256.0f) + EPS);
#pragma unroll
            for (int g = 0; g < 4; ++g) { const f32x4 g4 = *(const LAS f32x4*)(GG + 32 * wid + 8 * g + 4 * hh);
                *(LAS v2u*)(OI + ((32 * ib + l31) * 264 + 32 * wid + 8 * g + 4 * hh) * 2) = (v2u){pg8::cvt_pk_bf16(o[ib][4 * g + 0] * rinv * g4.x, o[ib][4 * g + 1] * rinv * g4.y), pg8::cvt_pk_bf16(o[ib][4 * g + 2] * rinv * g4.z, o[ib][4 * g + 3] * rinv * g4.w)}; } } }
        __syncthreads();
        { int tid = F.tid; OPQ(tid);
#pragma unroll
          for (int n = 0; n < 4; ++n) { const int idx = tid + 512 * n, row = idx >> 5, c8 = idx & 31; const v4u ov = *(const LAS v4u*)(OI + (row * 264 + 8 * c8) * 2); const v4u gv = sgv[n];
              v4u y; y.x = pg8::cvt_pk_bf16(bflo(ov.x) * bflo(gv.x), bfhi(ov.x) * bfhi(gv.x)); y.y = pg8::cvt_pk_bf16(bflo(ov.y) * bflo(gv.y), bfhi(ov.y) * bfhi(gv.y));
              y.z = pg8::cvt_pk_bf16(bflo(ov.z) * bflo(gv.z), bfhi(ov.z) * bfhi(gv.z)); y.w = pg8::cvt_pk_bf16(bflo(ov.w) * bflo(gv.w), bfhi(ov.w) * bfhi(gv.w));
              *(v4u*)((char*)zc + (unsigned)((row * LDZ + ZGG + h * 256 + 8 * c8) * 2)) = y; } }
        }
        __syncthreads();
    }
#undef GLA_LOAD_RAW
#undef GLA_LOAD_QK
#undef GLA_LOAD_V
#undef GLA_LD_K
#undef GLA_LD_Q
#undef GLA_LD_G
#undef GLA_LD_V
#undef GLA_LD_S
    if (Sout) { int ln = F.lane; OPQ(ln); const int hh = ln >> 5, l31 = ln & 31;
      if constexpr (SO) {
#pragma unroll
        for (int kb = 0; kb < 4; ++kb)
#pragma unroll
          for (int g = 0; g < 4; ++g) *(f32x4*)(Sout + (size_t)(((wid * 4 + kb) * 4 + g) * 64 + ln) * 4) = (f32x4){S[kb][4 * g + 0], S[kb][4 * g + 1], S[kb][4 * g + 2], S[kb][4 * g + 3]};
      } else {
#pragma unroll
        for (int kb = 0; kb < 4; ++kb)
#pragma unroll
          for (int r = 0; r < 16; ++r) { const int k = 32 * kb + (r & 3) + 8 * (r >> 2) + 4 * hh; Sout[(size_t)k * 256 + 32 * wid + l31] = S[kb][r]; } } }
    if (Bout && wid < 4 && F.lane < 32) Bout[32 * wid + F.lane] = bsum;
    __syncthreads();
}

__global__ void __launch_bounds__(NWAVES * 64, 2) mk_fwd(Args A) {
    extern __shared__ __attribute__((aligned(16))) unsigned char lds[];
    Frame F;
    F.lds = (LAS unsigned char*)lds;
    F.tid = threadIdx.x; F.lane = F.tid & 63; F.wave = __builtin_amdgcn_readfirstlane(F.tid >> 6); F.G = gridDim.x;
#define REFRESH_F() do { int t_ = threadIdx.x; OPQ(t_); F.tid = t_; F.lane = t_ & 63; } while (0)
    const int lo = A.ph_lo, hi = A.ph_hi;
#ifndef PHASE_MASK
#define PHASE_MASK 63
#endif
#ifndef REPEAT_MASK
#define REPEAT_MASK 0
#endif
#define REP(k) (((REPEAT_MASK >> (k)) & 1) ? 2 : 1)
#define IN(k) (((PHASE_MASK >> (k)) & 1) && lo <= (k) && (k) < hi)
#define BOTH(k) (IN(k) && IN((k) + 1))
#if MK_N_LAUNCHES == 1
    for (int u = F.tid; u < (LDS_BYTES - LDSCTL_OFF) / 4; u += NWAVES * 64) ((LAS unsigned*)(F.lds + LDSCTL_OFF))[u] = 0u;
    __syncthreads();
    const XcdBarrier bar = xcd_barrier_post((unsigned*)(A.ws + WS_CTL) + CW_BAR, (volatile LAS unsigned*)(F.lds + MISC_OFF) + 8);
#define GRID_BAR0() xcd_barrier(bar)
#define GRID_BAR() xcd_barrier(bar)
#else
#define GRID_BAR0() do {} while (0)
#define GRID_BAR() do {} while (0)
#endif
    if (IN(0)) { for (int rep = 0; rep < REP(0); ++rep) p0_prologue(F, A); if (BOTH(0)) GRID_BAR0(); }
    if (IN(1)) for (int rep = 0; rep < REP(1); ++rep) {
        pg8::Gemm g{A_XN(A), A_WINT(A), DM, DM, DM, 0}; pg8::StaticOrder S; S.init(NM, NINP / 256, F.G, (int)blockIdx.x);
        EpiZ E{A_Z(A), A_PSCALE(A)};
        pg8::gemm_phase<EpiZ, pg8::StaticOrder, true>(F.lds, g, S, E);
        REFRESH_F();
        if (BOTH(1)) GRID_BAR();
    }
    if (IN(3)) {
        float* SLOC = (float*)(A.ws + WS_SLOC); float* BSEG = (float*)(A.ws + WS_BSEG);
        newpool_copy(F, A);
        const int G = F.G, blk = (int)blockIdx.x;
        const bool pool_first = blk < 192 && (blk & 1);
#define P3A_GLA() do { for (int u = blk; u < 256; u += G) { \
                if (u < 192) { const int b = u / 12, h = (u % 12) / 3, seg = u % 3; \
                    gla_unit<true>(F, A, b * TP + seg * 512, 8, h, 0, nullptr, nullptr, false, SLOC + (size_t)u * 32768, BSEG + (size_t)u * 128); } \
                else { const int us = u - 192, b = us >> 2, h = us & 3; \
                    gla_unit<false>(F, A, MP + b * TS, 1, h, 1, A_SGLA(A) + (size_t)us * 32768, A_BGU(A), true, A.out + O_NGS + (size_t)us * 32768, nullptr); } } } while (0)
#define P3A_POOL() do { int ub, ue; if (blk < 192) { ub = (blk >> 6) * 256 + (blk & 63) * 4; ue = ub + 4; } else { const int k = blk - 192; if (k < 56) { ub = 768 + (k < 32 ? 5 * k : 160 + 4 * (k - 32)); ue = ub + (k < 32 ? 5 : 4); } else { ub = 1024 + 4 * (k - 56); ue = ub + 4; } } \
            if (G == 256) pool_run(F, A, ub, ue); else if (blk == 0) pool_run(F, A, 0, NM * 8); REFRESH_F(); } while (0)
        if (pool_first) { P3A_POOL(); P3A_GLA(); } else { P3A_GLA(); P3A_POOL(); }
#undef P3A_GLA
#undef P3A_POOL
        REFRESH_F();
        GRID_BAR();
        if ((blk & 3) == 0) {
            const int q = blk >> 2, ks = q & 3;
            pg8::Gemm g{A_Z(A) + ZGP + 512 * ks, A_WOUTT(A) + 512 * ks, LDZ, 2048, 512, 0}; OneUnit S1{128 + (q >> 4), (q >> 2) & 3};
            EpiSlab E{(float*)(A.ws + WS_SLAB) + (size_t)q * 65536};
            pg8::gemm_phase<EpiSlab, OneUnit, true>(F.lds, g, S1, E); REFRESH_F(); }
        for (int u = blk; u < 256; u += G) { const int b = u >> 4, h = (u >> 2) & 3, seg = u & 3; const int sl = (b * 4 + h) * 3;
            gla_unit<false>(F, A, b * TP + seg * 512, 8, h, seg, SLOC + (size_t)sl * 32768, BSEG + (size_t)sl * 128, false, seg == 3 ? A.out + O_NGP + (size_t)(b * 4 + h) * 32768 : nullptr, nullptr); }
        if (BOTH(3)) GRID_BAR();
    }
    if (IN(4)) {
        { const int gw = blockIdx.x * NWAVES + F.wave;
          if (gw < MS) { const int r = gw, pnl = r >> 8, rt = r & 255; const float* slab = (const float*)(A.ws + WS_SLAB);
            f32x4 raw[4]; float s2 = 0.f;
#pragma unroll
            for (int pn = 0; pn < 4; ++pn) { f32x4 a = (f32x4){0.f, 0.f, 0.f, 0.f};
#pragma unroll
                for (int ks = 0; ks < 4; ++ks) a = a + *(const f32x4*)(slab + (size_t)(((pnl * 4 + pn) * 4 + ks)) * 65536 + rt * 256 + 4 * F.lane);
                raw[pn] = a; s2 += (a.x * a.x + a.y * a.y) + (a.z * a.z + a.w * a.w); }
            const float rinv = 1.0f / sqrtf(wave_sum(s2) * (1.f / DM) + EPS);
#pragma unroll
            for (int pn = 0; pn < 4; ++pn) { const int c = pn * 256 + 4 * F.lane; const f32x4 xv = *(const f32x4*)(A_XS(A) + (size_t)r * DM + c), gp = *(const f32x4*)(A_GPOST(A) + c);
                *(f32x4*)(A.out + (size_t)(MP + r) * DM + c) = xv + raw[pn] * rinv * gp; } } }
        pg8::Gemm g{A_Z(A) + ZGP, A_WOUTT(A), LDZ, 2048, 2048, 0}; PanelOrder S{(int)blockIdx.x, 128};
        EpiRmsRes E{A_XP(A), A_XS(A), A_GPOST(A), A.out, A_PART(A), (unsigned*)(A.ws + WS_CTL) + CW_CNT, F.lds};
        pg8::gemm_phase<EpiRmsRes, PanelOrder, true>(F.lds, g, S, E);
    }
#undef IN
#undef BOTH
}

extern "C" void kernel_launch(void* const* d_in, const int* in_sizes, int n_in, void* d_out, int out_size, void* d_ws, size_t ws_size, hipStream_t stream) {
    static int grid = 0;
    if (grid == 0) {
        if (n_in != 13 || in_sizes[0] != MP * DM || (size_t)out_size != O_END || ws_size < WS_END) {
            fprintf(stderr, "kernel_launch: unexpected shapes: n_in %d in0 %d out %d ws %zu (need %zu)\n", n_in, n_in > 0 ? in_sizes[0] : -1, out_size, ws_size, (size_t)WS_END); grid = -1; return; }
        int dev = 0, cus = 0, per_cu = 0;
        if (hipGetDevice(&dev) != hipSuccess || hipDeviceGetAttribute(&cus, hipDeviceAttributeMultiprocessorCount, dev) != hipSuccess) { grid = -1; return; }
        if (hipFuncSetAttribute((const void*)mk_fwd, hipFuncAttributeMaxDynamicSharedMemorySize, LDS_BYTES) != hipSuccess) { fprintf(stderr, "kernel_launch: hipFuncSetAttribute failed\n"); grid = -1; return; }
        if (hipOccupancyMaxActiveBlocksPerMultiprocessor(&per_cu, (const void*)mk_fwd, NWAVES * 64, LDS_BYTES) != hipSuccess || per_cu < 1) { fprintf(stderr, "kernel_launch: occupancy query failed (%d)\n", per_cu); (void)hipGetLastError(); grid = -1; return; }
        if (cus != 256) { fprintf(stderr, "kernel_launch: built for a 256-CU device (got %d)\n", cus); grid = -1; return; }
        grid = cus;
    }
    if (grid < 0) return;
    (void)hipMemsetAsync((char*)d_ws + WS_CTL, 0, CTL_ZERO_BYTES, stream);
    Args a{};
    for (int i = 0; i < 13; ++i) a.in[i] = (const float*)d_in[i];
    a.out = (float*)d_out; a.ws = (unsigned char*)d_ws;
#if MK_N_LAUNCHES == 1
    a.ph_lo = 0; a.ph_hi = 6;
    void* kargs[] = {&a};
    hipError_t e = hipLaunchCooperativeKernel((const void*)mk_fwd, dim3(grid), dim3(NWAVES * 64), kargs, LDS_BYTES, stream);
    if (e != hipSuccess) fprintf(stderr, "cooperative launch failed: %s (grid %d)\n", hipGetErrorString(e), grid);
#else
    for (int li = 0; li < 6; ++li) { a.ph_lo = li; a.ph_hi = li + 1; hipLaunchKernelGGL(mk_fwd, dim3(grid), dim3(NWAVES * 64), LDS_BYTES, stream, a); }
#endif
}
```

```cpp
#include <hip/hip_runtime.h>
#include <hip/hip_cooperative_groups.h>
#include <cstdio>
#include <cstdint>
namespace cg = cooperative_groups;

#ifndef MK_N_LAUNCHES
#define MK_N_LAUNCHES 1
#endif

namespace pg8 {
#define PG8_LAS __attribute__((address_space(3)))
typedef unsigned short bf16_t;
typedef short bf16x8 __attribute__((ext_vector_type(8)));
typedef float f32x4 __attribute__((ext_vector_type(4)));
typedef unsigned u32x4 __attribute__((ext_vector_type(4)));
constexpr int BM = 256, BK = 64, HALF = 128, HTB = HALF * BK * 2  , STAGE_BYTES = 8 * HTB, NXCD = 8, WGM = 8;

__host__ __device__ __forceinline__ int lds_byte(int r, int c) { const int st = (r >> 4) * 2 + (c >> 5), rr = r & 15, cc = c & 31, ob = rr * 64 + cc * 2; return st * 1024 + (ob ^ (((ob >> 9) & 1) << 5)); }
__host__ __device__ __forceinline__ void stage_rc(int b, int& R, int& C) { const int st = b / 1024, sb = b % 1024, swz = sb ^ (((sb >> 9) & 1) << 5); R = (st >> 1) * 16 + swz / 64; C = (st & 1) * 32 + (swz % 64) / 2; }
__host__ __device__ __forceinline__ int perm32(int rho) { const int n = rho >> 4, i = rho & 15; return 8 * (i >> 2) + 4 * n + (i & 3); }

struct Unit { int pm, pn; };
struct Gemm { const bf16_t* A; const bf16_t* Bt; int lda, ldb, K, aShift; };

struct StaticOrder {
    int nM, nN, nwg, G, c;
    __host__ __device__ __forceinline__ void init(int nM_, int nN_, int G_, int c_) { nM = nM_; nN = nN_; nwg = nM * nN; G = G_; c = c_; }
    __host__ __device__ __forceinline__ bool next(int i, Unit& u) const {
        const long L = (long)i * G + c; if (L >= nwg) return false;
        int wgid = (int)L; { const int q = nwg / NXCD, r = nwg % NXCD, xcd = wgid % NXCD, off = wgid / NXCD; wgid = (xcd < r ? xcd * (q + 1) : r * (q + 1) + (xcd - r) * q) + off; }
        const int nig = WGM * nN, gid = wgid / nig, fm = gid * WGM, gsz = (nM - fm) < WGM ? (nM - fm) : WGM;
        u.pm = fm + ((wgid % nig) % gsz); u.pn = (wgid % nig) / gsz; return true;
    }
};

__device__ __forceinline__ unsigned cvt_pk_bf16(float lo, float hi) { unsigned r; asm volatile("v_cvt_pk_bf16_f32 %0, %1, %2" : "=v"(r) : "v"(lo), "v"(hi)); return r; }

template <class Epi, class Sched, bool ALIGN_EPI>
__device__ __forceinline__ void gemm_phase(PG8_LAS unsigned char* lds, const Gemm g, const Sched& S, const Epi& E) {
    int tid_ = threadIdx.x; asm volatile("" : "+v"(tid_));
    const int tid = tid_, wid = __builtin_amdgcn_readfirstlane(tid >> 6), lane = tid & 63, wr = wid >> 2, wc = wid & 3, fr = lane & 15, fq = lane >> 4;
    const int K = g.K, nt = K / BK;
    unsigned voffA[2], voffB[2];
#pragma unroll
    for (int i = 0; i < 2; ++i) { int R, C; stage_rc(tid * 16 + i * 8192, R, C); const int Rb = Epi::PERM ? ((R & ~31) + perm32(R & 31)) : R;
        voffA[i] = (unsigned)(R * g.lda + C) * 2u; voffB[i] = (unsigned)(Rb * g.ldb + C) * 2u; }
    const size_t kstep = (size_t)(BK * 2);
    const size_t hstepA = (size_t)HALF * g.lda * 2, hstepB = (size_t)HALF * g.ldb * 2;
    const size_t tstepA = 2 * hstepA, tstepB = 2 * hstepB;
    const unsigned ldsw = (unsigned)wid * 1024u;
    const int aoff = lds_byte(wr * 64 + fr, fq * 8), boff = lds_byte(wc * 32 + fr, fq * 8);
#define PG8_SA(b, h) (((b) * 2 + (h)) * HTB)
#define PG8_SB(b, h) ((4 + (b) * 2 + (h)) * HTB)
#define PG8_STAGE(bufoff, gbase, voff) do { _Pragma("unroll") for (int _i = 0; _i < 2; ++_i) \
        __builtin_amdgcn_global_load_lds((const unsigned*)((const char*)(gbase) + (voff)[_i]), (PG8_LAS unsigned*)(lds + (bufoff) + ldsw + _i * 8192), 16, 0, 0); } while (0)
#define PG8_LDA(dst, b, h) do { _Pragma("unroll") for (int m = 0; m < 4; ++m) _Pragma("unroll") for (int k = 0; k < 2; ++k) dst[m][k] = *(const PG8_LAS bf16x8*)(lds + PG8_SA(b, h) + aoff + m * 2048 + k * 1024); } while (0)
#define PG8_LDB(dst, b, h) do { _Pragma("unroll") for (int n = 0; n < 2; ++n) _Pragma("unroll") for (int k = 0; k < 2; ++k) dst[n][k] = *(const PG8_LAS bf16x8*)(lds + PG8_SB(b, h) + boff + n * 2048 + k * 1024); } while (0)
#define PG8_MMA(ai, bj, At, Bt) do { __builtin_amdgcn_s_setprio(1); _Pragma("unroll") for (int m = 0; m < 4; ++m) _Pragma("unroll") for (int n = 0; n < 2; ++n) _Pragma("unroll") for (int k = 0; k < 2; ++k) \
        acc[ai][bj][m][n] = __builtin_amdgcn_mfma_f32_16x16x32_bf16(Bt[n][k], At[m][k], acc[ai][bj][m][n], 0, 0, 0); __builtin_amdgcn_s_setprio(0); } while (0)
#define PG8_WAIT_V(n) asm volatile("s_waitcnt vmcnt(" #n ")" ::: "memory")
#define PG8_WAIT_L(n) asm volatile("s_waitcnt lgkmcnt(" #n ")" ::: "memory")
#define PG8_BAR __builtin_amdgcn_s_barrier()
#define PG8_SCHED __builtin_amdgcn_sched_barrier(0)
    Unit cur, nxt; int ui = 0;
    if (!S.next(0, cur)) return;
    f32x4 acc[2][2][4][2];
#pragma unroll
    for (int a = 0; a < 2; ++a)
#pragma unroll
        for (int b = 0; b < 2; ++b)
#pragma unroll
            for (int m = 0; m < 4; ++m)
#pragma unroll
                for (int n = 0; n < 2; ++n) acc[a][b][m][n] = (f32x4){0.f, 0.f, 0.f, 0.f};
    bf16x8 At[4][2], B0[2][2], B1[2][2];
    const char* cA = (const char*)g.A + (size_t)cur.pm * tstepA + (size_t)cur.pn * g.aShift; const char* cB = (const char*)g.Bt + (size_t)cur.pn * tstepB;
    PG8_STAGE(PG8_SB(0, 0), cB, voffB); PG8_STAGE(PG8_SB(0, 1), cB + hstepB, voffB); PG8_STAGE(PG8_SA(0, 0), cA, voffA); PG8_STAGE(PG8_SA(0, 1), cA + hstepA, voffA);
    if (wr == 1) PG8_BAR;
    PG8_WAIT_V(2); PG8_BAR;
    PG8_STAGE(PG8_SB(1, 0), cB + kstep, voffB); PG8_STAGE(PG8_SA(1, 0), cA + kstep, voffA); PG8_STAGE(PG8_SB(1, 1), cB + hstepB + kstep, voffB);
    PG8_WAIT_V(6); PG8_BAR;
    for (;;) {
        const bool has_next = S.next(ui + 1, nxt);
        const char* nA = has_next ? (const char*)g.A + (size_t)nxt.pm * tstepA + (size_t)nxt.pn * g.aShift : cA; const char* nB = has_next ? (const char*)g.Bt + (size_t)nxt.pn * tstepB : cB;
        for (int t = 0; t < nt; t += 2) {
            const bool last = (t == nt - 2);
            const char* a1 = cA + (size_t)(t + 1) * kstep;
            const char* a2 = last ? nA : cA + (size_t)(t + 2) * kstep; const char* b2 = last ? nB : cB + (size_t)(t + 2) * kstep;
            const char* a3 = a2 + kstep; const char* b3 = b2 + kstep;
            PG8_LDB(B0, 0, 0); PG8_LDB(B1, 0, 1); PG8_SCHED; PG8_LDA(At, 0, 0); PG8_STAGE(PG8_SA(1, 1), a1 + hstepA, voffA);
            PG8_WAIT_V(8); PG8_WAIT_L(0); PG8_BAR; PG8_MMA(0, 0, At, B0); PG8_MMA(0, 1, At, B1); PG8_BAR; PG8_SCHED;
            PG8_LDA(At, 0, 1); PG8_STAGE(PG8_SB(0, 0), b2, voffB); PG8_STAGE(PG8_SB(0, 1), b2 + hstepB, voffB); PG8_STAGE(PG8_SA(0, 0), a2, voffA);
            PG8_WAIT_V(8); PG8_WAIT_L(0); PG8_BAR; PG8_MMA(1, 0, At, B0); PG8_MMA(1, 1, At, B1); PG8_BAR; PG8_SCHED;
            PG8_LDB(B0, 1, 0); PG8_LDB(B1, 1, 1); PG8_SCHED; PG8_LDA(At, 1, 0); PG8_STAGE(PG8_SA(0, 1), a2 + hstepA, voffA);
            PG8_WAIT_V(8); PG8_WAIT_L(0); PG8_BAR; PG8_MMA(0, 0, At, B0); PG8_MMA(0, 1, At, B1); PG8_BAR; PG8_SCHED;
            PG8_LDA(At, 1, 1); PG8_STAGE(PG8_SB(1, 0), b3, voffB); PG8_STAGE(PG8_SB(1, 1), b3 + hstepB, voffB); PG8_STAGE(PG8_SA(1, 0), a3, voffA);
            PG8_WAIT_V(8); PG8_WAIT_L(0); PG8_BAR; PG8_MMA(1, 0, At, B0); PG8_MMA(1, 1, At, B1); PG8_BAR; PG8_SCHED;
        }
        if constexpr (ALIGN_EPI) { if (wr == 0) PG8_BAR; }
        E(acc, cur, wr, wc, fr, fq);
        if (!has_next) break;
#pragma unroll
        for (int a = 0; a < 2; ++a)
#pragma unroll
            for (int b = 0; b < 2; ++b)
#pragma unroll
                for (int m = 0; m < 4; ++m)
#pragma unroll
                    for (int n = 0; n < 2; ++n) acc[a][b][m][n] = (f32x4){0.f, 0.f, 0.f, 0.f};
        cur = nxt; cA = nA; cB = nB; ++ui;
        if constexpr (ALIGN_EPI) { if (wr == 1) PG8_BAR; }
    }
    PG8_WAIT_V(0);
    if constexpr (!ALIGN_EPI) { if (wr == 0) PG8_BAR; }
    PG8_BAR;
#undef PG8_SA
#undef PG8_SB
#undef PG8_STAGE
#undef PG8_LDA
#undef PG8_LDB
#undef PG8_MMA
#undef PG8_WAIT_V
#undef PG8_WAIT_L
#undef PG8_BAR
#undef PG8_SCHED
}
}

constexpr int NWAVES = 8;
constexpr int DM = 1024, NBP = 16, TP = 2048, NBS = 16, TS = 64;
constexpr int MP = NBP * TP, MS = NBS * TS, M = MP + MS;
constexpr int LDZ = 5184;
constexpr int ZU = 0, ZQ = 1024, ZK = 1536, ZV = 2048, ZGP = 3072, ZGG = 4096, ZLR = 5120;
constexpr int NIN = 5136, NINP = 5376;
constexpr int NM = M / 256;
constexpr float EPS = 1e-6f;
constexpr size_t O_Y = 0, O_NPP = (size_t)M * DM, O_NGP = O_NPP + 16 * 15 * 1024, O_NPS = O_NGP + 16 * 4 * 128 * 256, O_NGS = O_NPS + 16 * 15 * 1024, O_END = O_NGS + 16 * 4 * 128 * 256;

constexpr size_t MiB = 1u << 20;
constexpr size_t WS_CTL = 0, CTL_ZERO_BYTES = 48 * 1024;
constexpr size_t WS_WIN = 2 * MiB;
constexpr size_t WS_WOUT = 13 * MiB;
constexpr size_t WS_WP = 17 * MiB;
constexpr size_t WS_PART = 18 * MiB;
constexpr size_t WS_XN = 24 * MiB;
constexpr size_t WS_Z = 96 * MiB;
constexpr size_t WS_ZEND = WS_Z + (size_t)M * LDZ * 2;
constexpr size_t WS_SLOC = 432 * MiB;
constexpr size_t WS_BSEG = 457 * MiB;
constexpr size_t WS_SLAB = 460 * MiB;
constexpr size_t WS_END = 476 * MiB;
static_assert(WS_ZEND <= WS_SLOC && WS_SLOC + 192ull * 131072 <= WS_BSEG, "ws map 2");
static_assert(WS_WIN + (size_t)NINP * 1024 * 2 <= WS_WOUT && WS_PART + (size_t)M * 64 <= WS_XN && WS_XN + (size_t)M * 2048 <= WS_Z, "ws map");
constexpr int CW_BAR = 0;

constexpr int RING_BYTES = 131072;
constexpr int PU_STG = 65536, PU_STG_BYTES = 144 * 512;
constexpr int CTL_BASE = PU_STG + PU_STG_BYTES;
constexpr int LDSCTL_OFF = CTL_BASE, MISC_OFF = LDSCTL_OFF + 320;
constexpr int LDS_BYTES = CTL_BASE + 16384;

#define GAS __attribute__((address_space(1)))
#define LAS __attribute__((address_space(3)))
typedef unsigned short bf16;
typedef unsigned v4u __attribute__((ext_vector_type(4)));
typedef unsigned v2u __attribute__((ext_vector_type(2)));
typedef float f32x2v __attribute__((ext_vector_type(2)));
typedef float f32x4 __attribute__((ext_vector_type(4)));
typedef float f32x16 __attribute__((ext_vector_type(16)));
typedef short bf16x8 __attribute__((ext_vector_type(8)));
typedef GAS unsigned gu32;
#define RLX_AGENT __ATOMIC_RELAXED, __HIP_MEMORY_SCOPE_AGENT
#define LDS_WAIT() asm volatile("s_waitcnt lgkmcnt(0)" ::: "memory")
__device__ __forceinline__ unsigned f2bf(float f) { unsigned u = __builtin_bit_cast(unsigned, f); return (u + 0x7fffu + ((u >> 16) & 1u)) >> 16; }
__device__ __forceinline__ unsigned pk2(float lo, float hi) { return f2bf(lo) | (f2bf(hi) << 16); }
__device__ __forceinline__ float bf2f(unsigned u16) { return __builtin_bit_cast(float, u16 << 16); }
__device__ __forceinline__ float bflo(unsigned w) { return __builtin_bit_cast(float, w << 16); }
__device__ __forceinline__ float bfhi(unsigned w) { return __builtin_bit_cast(float, w & 0xffff0000u); }
__device__ __forceinline__ float silu_f(float x) { return x * __builtin_amdgcn_rcpf(1.0f + __expf(-x)); }

#define XB_TMO      128
#define XB_XCNT(j)  (256  + 64 * (j))
#define XB_XSUB(j)  (1280 + 64 * (j))
#define XB_XGEN(j)  (2304 + 64 * (j))
#define XB_TOP      3328
#define XB_TOPGEN   3392
#define XCD_BAR_WORDS 3456
#define XB_SPIN_CAP (1u << 18)
__device__ __forceinline__ unsigned xb_ld(unsigned* p)              { return __hip_atomic_load(p, __ATOMIC_RELAXED, __HIP_MEMORY_SCOPE_AGENT); }
__device__ __forceinline__ unsigned xb_add(unsigned* p, unsigned v) { return __hip_atomic_fetch_add(p, v, __ATOMIC_RELAXED, __HIP_MEMORY_SCOPE_AGENT); }
__device__ __forceinline__ unsigned xb_xcc_id() { return (unsigned)__builtin_amdgcn_s_getreg((3 << 11) | 20) & 0xFu; }
#define XB_SPIN(cond, bar) do { unsigned _sp = 0; while (cond) { __builtin_amdgcn_s_sleep(1); \
    if ((++_sp & 255u) == 0u) { if (xb_ld(&(bar)[XB_TMO])) break; if (_sp > XB_SPIN_CAP) { atomicAdd(&(bar)[XB_TMO], 1u); break; } } } } while (0)
struct XcdBarrier { unsigned* bar; unsigned x; volatile LAS unsigned* st; };
__device__ __forceinline__ XcdBarrier xcd_barrier_post(unsigned* bar, volatile LAS unsigned* st) {
    XcdBarrier b; b.bar = bar; b.x = xb_xcc_id(); b.st = st;
    if (threadIdx.x == 0) (void)xb_add(&bar[XB_XCNT(b.x)], 1u);
    return b;
}
__device__ __forceinline__ void xcd_barrier_complete(unsigned* bar, unsigned x, unsigned& nloc, unsigned& nx) {
    const unsigned G = gridDim.x * gridDim.y * gridDim.z;
    unsigned sum, cnt, mine, sp = 0u;
    for (;;) {
        sum = 0u; cnt = 0u; mine = 0u;
#pragma unroll
        for (unsigned j = 0; j < 16; ++j) { const unsigned c = xb_ld(&bar[XB_XCNT(j)]); sum += c; cnt += (c > 0u) ? 1u : 0u; mine = (j == x) ? c : mine; }
        if (sum == G) break;
        __builtin_amdgcn_s_sleep(1);
        if ((++sp & 255u) == 0u) { if (xb_ld(&bar[XB_TMO])) break; if (sp > XB_SPIN_CAP) { atomicAdd(&bar[XB_TMO], 1u); break; } }
    }
    nloc = mine > 0u ? mine : 1u; nx = cnt > 0u ? cnt : 1u;
}
__device__ __forceinline__ void xcd_barrier(const XcdBarrier& b) {
    asm volatile("s_waitcnt vmcnt(0)" ::: "memory");
    __syncthreads();
    if (threadIdx.x == 0) {
        unsigned* bar = b.bar;
        __builtin_amdgcn_s_waitcnt(0);
        unsigned nloc = b.st[0], nx = b.st[1];
        if (nloc == 0u) { xcd_barrier_complete(bar, b.x, nloc, nx); b.st[0] = nloc; b.st[1] = nx; }
        const unsigned old = xb_add(&bar[XB_XSUB(b.x)], 1u);
        const unsigned gen = old / nloc;
        if (old + 1u == (gen + 1u) * nloc) {
            __builtin_amdgcn_fence(__ATOMIC_RELEASE, "agent");
            asm volatile("s_waitcnt vmcnt(0)" ::: "memory");
            const unsigned og = xb_add(&bar[XB_TOP], 1u);
            const unsigned tg = og / nx;
            if (og + 1u == (tg + 1u) * nx) xb_add(&bar[XB_TOPGEN], 1u);
            else XB_SPIN(xb_ld(&bar[XB_TOPGEN]) == tg, bar);
            __builtin_amdgcn_fence(__ATOMIC_ACQUIRE, "agent");
            xb_add(&bar[XB_XGEN(b.x)], 1u);
            asm volatile("s_waitcnt vmcnt(0)" ::: "memory");
        } else {
            XB_SPIN(xb_ld(&bar[XB_XGEN(b.x)]) == gen, bar);
            __builtin_amdgcn_fence(__ATOMIC_ACQUIRE, "agent");
            asm volatile("s_waitcnt vmcnt(0)" ::: "memory");
        }
    }
    __syncthreads();
}

struct EpiZ {
    static constexpr bool PERM = true;
    bf16* Z; const float* pscale;
    __device__ __forceinline__ void operator()(const f32x4 (&acc)[2][2][4][2], const pg8::Unit& u, int wr, int wc, int fr, int fq) const {
        const int row0 = u.pm * 256 + wr * 64 + fr, col0 = u.pn * 256 + wc * 32 + 8 * fq;
        const int pn = u.pn; const bool dosilu = (pn >= 12 && pn < 20), lr = (pn == 20);
        const float sc = (pn == 4 || pn == 5) ? 0.08838834764831845f : 1.0f;
#pragma unroll
        for (int ai = 0; ai < 2; ++ai)
#pragma unroll
            for (int m = 0; m < 4; ++m) { bf16* rowp = Z + (size_t)(row0 + ai * 128 + m * 16) * LDZ + col0;
#pragma unroll
                for (int bj = 0; bj < 2; ++bj) { f32x4 v0 = acc[ai][bj][m][0], v1 = acc[ai][bj][m][1];
                    if (dosilu) { v0 = (f32x4){silu_f(v0[0]), silu_f(v0[1]), silu_f(v0[2]), silu_f(v0[3])}; v1 = (f32x4){silu_f(v1[0]), silu_f(v1[1]), silu_f(v1[2]), silu_f(v1[3])}; }
                    v0 = v0 * sc; v1 = v1 * sc;
                    if (pn >= 12 && pn < 16) { v0 = v0 * *(const f32x4*)(pscale + col0 - ZGP + bj * 128); v1 = v1 * *(const f32x4*)(pscale + col0 - ZGP + bj * 128 + 4); }
                    v4u w; w.x = pg8::cvt_pk_bf16(v0[0], v0[1]); w.y = pg8::cvt_pk_bf16(v0[2], v0[3]); w.z = pg8::cvt_pk_bf16(v1[0], v1[1]); w.w = pg8::cvt_pk_bf16(v1[2], v1[3]);
                    if (!lr || (bj == 0 && wc == 0 && fq < 2)) *(v4u*)(rowp + bj * 128) = w; } }
    }
};
struct EpiPool {
    static constexpr bool PERM = true;
    bf16* Z;
    __device__ __forceinline__ void operator()(const f32x4 (&acc)[2][2][4][2], const pg8::Unit& u, int wr, int wc, int fr, int fq) const {
        const int row0 = u.pm * 256 + wr * 64 + fr, col0 = u.pn * 256 + wc * 32 + 8 * fq;
        bf16* base = Z + (size_t)row0 * LDZ + ZGP + col0;
#pragma unroll
        for (int ai = 0; ai < 2; ++ai)
#pragma unroll
          for (int mp = 0; mp < 2; ++mp) {
            v4u gs[2][2];
#pragma unroll
            for (int mm = 0; mm < 2; ++mm)
#pragma unroll
                for (int bj = 0; bj < 2; ++bj) gs[mm][bj] = *(const v4u*)(base + (size_t)(ai * 128 + (2 * mp + mm) * 16) * LDZ + bj * 128);
            __builtin_amdgcn_sched_barrier(0);
#pragma unroll
            for (int mm = 0; mm < 2; ++mm)
#pragma unroll
                for (int bj = 0; bj < 2; ++bj) { const int m = 2 * mp + mm; const v4u gsg = gs[mm][bj];
                    const f32x4 v0 = acc[ai][bj][m][0] * (f32x4){bflo(gsg.x), bfhi(gsg.x), bflo(gsg.y), bfhi(gsg.y)}, v1 = acc[ai][bj][m][1] * (f32x4){bflo(gsg.z), bfhi(gsg.z), bflo(gsg.w), bfhi(gsg.w)};
                    v4u w; w.x = pg8::cvt_pk_bf16(v0[0], v0[1]); w.y = pg8::cvt_pk_bf16(v0[2], v0[3]); w.z = pg8::cvt_pk_bf16(v1[0], v1[1]); w.w = pg8::cvt_pk_bf16(v1[2], v1[3]);
                    *(v4u*)(base + (size_t)(ai * 128 + m * 16) * LDZ + bj * 128) = w; }
            __builtin_amdgcn_sched_barrier(0);
          }
    }
};
struct OneUnit { int pm, pn; __device__ __forceinline__ bool next(int i, pg8::Unit& u) const { if (i) return false; u.pm = pm; u.pn = pn; return true; } };
struct EpiSlab {
    static constexpr bool PERM = false;
    float* slab;
    __device__ __forceinline__ void operator()(const f32x4 (&acc)[2][2][4][2], const pg8::Unit&, int wr, int wc, int fr, int fq) const {
#pragma unroll
        for (int ai = 0; ai < 2; ++ai)
#pragma unroll
            for (int m = 0; m < 4; ++m) { float* rowp = slab + (size_t)(ai * 128 + wr * 64 + m * 16 + fr) * 256 + wc * 32 + 4 * fq;
#pragma unroll
                for (int bj = 0; bj < 2; ++bj)
#pragma unroll
                    for (int n = 0; n < 2; ++n) *(f32x4*)(rowp + bj * 128 + n * 16) = acc[ai][bj][m][n]; }
    }
};
struct PanelOrder {
    int c, npanel;
    __device__ __forceinline__ bool next(int i, pg8::Unit& u) const { const int x = c & 7, y = c >> 3; const int p = i * 64 + x * 8 + (y >> 2); if (p >= npanel) return false; u.pm = p; u.pn = y & 3; return true; }
};
constexpr int CW_CNT = 3584;
constexpr int XL_OFF = CTL_BASE + 1024;
struct EpiRmsRes {
    static constexpr bool PERM = false;
    const float* xp; const float* xs; const float* gpost; float* out; float* xbuf; unsigned* cnt; LAS unsigned char* lds;
    __device__ __forceinline__ void operator()(const f32x4 (&acc)[2][2][4][2], const pg8::Unit& u, int wr, int wc, int fr, int fq) const {
        LAS float* P = (LAS float*)(lds + XL_OFF); LAS float* S = (LAS float*)(lds + XL_OFF + 4096); LAS unsigned* flag = (LAS unsigned*)(lds + XL_OFF + 5120);
        const int tid = threadIdx.x, wid = __builtin_amdgcn_readfirstlane(tid >> 6), lane = tid & 63;
        const int col0 = u.pn * 256 + wc * 32 + 4 * fq;
        const int prow0 = u.pm * 256;
        const float* xbase = prow0 < MP ? xp + (size_t)prow0 * DM : xs + (size_t)(prow0 - MP) * DM;
        f32x4 xa[2][2], xb[2][2];
#define RMS_LOADX(buf, grp) do { const size_t off_ = (size_t)(((grp) >> 2) * 128 + wr * 64 + ((grp) & 3) * 16 + fr) * DM + col0; \
            _Pragma("unroll") for (int bj = 0; bj < 2; ++bj) _Pragma("unroll") for (int n = 0; n < 2; ++n) buf[bj][n] = *(const f32x4*)(xbase + off_ + bj * 128 + n * 16); } while (0)
        RMS_LOADX(xa, 0); RMS_LOADX(xb, 1);
#pragma unroll
        for (int ai = 0; ai < 2; ++ai)
#pragma unroll
            for (int m = 0; m < 4; ++m) { float s = 0.f;
#pragma unroll
                for (int bj = 0; bj < 2; ++bj)
#pragma unroll
                    for (int n = 0; n < 2; ++n) { const f32x4 x = acc[ai][bj][m][n]; s += (x[0] * x[0] + x[1] * x[1]) + (x[2] * x[2] + x[3] * x[3]); }
                s += __shfl_xor(s, 16); s += __shfl_xor(s, 32);
                if (fq == 0) P[(ai * 128 + wr * 64 + m * 16 + fr) * 4 + wc] = s; }
        asm volatile("s_waitcnt lgkmcnt(0)" ::: "memory"); __builtin_amdgcn_s_barrier(); asm volatile("" ::: "memory");
        if (wid < 4) { const f32x4 p4 = *(const LAS f32x4*)(P + tid * 4); const float rs = (p4.x + p4.y) + (p4.z + p4.w);
            __hip_atomic_store((unsigned*)xbuf + (size_t)(prow0 + tid) * 4 + u.pn, __float_as_uint(rs), __ATOMIC_RELAXED, __HIP_MEMORY_SCOPE_AGENT);
            asm volatile("s_waitcnt vmcnt(0)" ::: "memory");
            if (lane == 0) __hip_atomic_fetch_add(cnt + 64 * u.pm, 1u, __ATOMIC_RELAXED, __HIP_MEMORY_SCOPE_AGENT); }
        if (wid == 0) { unsigned spins = 0;
            while ((unsigned)__builtin_amdgcn_readfirstlane(__hip_atomic_load(cnt + 64 * u.pm, __ATOMIC_RELAXED, __HIP_MEMORY_SCOPE_AGENT)) < 16u) { __builtin_amdgcn_s_sleep(2); if (++spins > (1u << 22)) break; }
            __builtin_amdgcn_fence(__ATOMIC_ACQUIRE, "agent");
            if (lane == 0) flag[0] = spins; }
        asm volatile("s_waitcnt vmcnt(0) lgkmcnt(0)" ::: "memory"); __builtin_amdgcn_s_barrier(); asm volatile("" ::: "memory");
        if (wid < 4) { const unsigned* slot = (const unsigned*)xbuf + (size_t)(prow0 + tid) * 4; float tot = 0.f;
#pragma unroll
            for (int t = 0; t < 4; ++t) tot += __uint_as_float(__hip_atomic_load(slot + t, __ATOMIC_RELAXED, __HIP_MEMORY_SCOPE_AGENT));
            S[tid] = __builtin_amdgcn_rsqf(tot * (1.0f / DM) + EPS); }
        asm volatile("s_waitcnt vmcnt(0) lgkmcnt(0)" ::: "memory"); __builtin_amdgcn_s_barrier(); asm volatile("" ::: "memory");
        f32x4 gp[2][2];
#pragma unroll
        for (int bj = 0; bj < 2; ++bj)
#pragma unroll
            for (int n = 0; n < 2; ++n) gp[bj][n] = *(const f32x4*)(gpost + col0 + bj * 128 + n * 16);
        float* obase = out + (size_t)prow0 * DM;
#define RMS_STORE(buf, grp) do { const int ai_ = (grp) >> 2, m_ = (grp) & 3; const int r_ = ai_ * 128 + wr * 64 + m_ * 16 + fr; const float rinv_ = S[r_]; const size_t off_ = (size_t)r_ * DM + col0; \
            _Pragma("unroll") for (int bj = 0; bj < 2; ++bj) _Pragma("unroll") for (int n = 0; n < 2; ++n) *(f32x4*)(obase + off_ + bj * 128 + n * 16) = buf[bj][n] + acc[ai_][bj][m_][n] * rinv_ * gp[bj][n]; } while (0)
#define SB __builtin_amdgcn_sched_barrier(0)
        RMS_STORE(xa, 0); SB; RMS_LOADX(xa, 2); SB; RMS_STORE(xb, 1); SB; RMS_LOADX(xb, 3); SB;
        RMS_STORE(xa, 2); SB; RMS_LOADX(xa, 4); SB; RMS_STORE(xb, 3); SB; RMS_LOADX(xb, 5); SB;
        RMS_STORE(xa, 4); SB; RMS_LOADX(xa, 6); SB; RMS_STORE(xb, 5); SB; RMS_LOADX(xb, 7); SB;
        RMS_STORE(xa, 6); SB; RMS_STORE(xb, 7);
#undef SB
#undef RMS_LOADX
#undef RMS_STORE
    }
};

struct Args { const float* in[13]; float* out; unsigned char* ws; int ph_lo, ph_hi; };
struct Frame {
    LAS unsigned char* lds;
    int tid, lane, wave, G;
};
#define A_XP(a) ((a).in[0])
#define A_XS(a) ((a).in[1])
#define A_SPOOL(a) ((a).in[2])
#define A_SGLA(a) ((a).in[3])
#define A_GPRE(a) ((a).in[4])
#define A_WIN(a) ((a).in[5])
#define A_WGU(a) ((a).in[6])
#define A_BGU(a) ((a).in[7])
#define A_WPOOL(a) ((a).in[8])
#define A_PSCALE(a) ((a).in[9])
#define A_GGO(a) ((a).in[10])
#define A_WOUT(a) ((a).in[11])
#define A_GPOST(a) ((a).in[12])
#define A_WINT(a) ((bf16*)((a).ws + WS_WIN))
#define A_WOUTT(a) ((bf16*)((a).ws + WS_WOUT))
#define A_WPT(a) ((bf16*)((a).ws + WS_WP))
#define A_XN(a) ((bf16*)((a).ws + WS_XN))
#define A_Z(a) ((bf16*)((a).ws + WS_Z))
#define A_PART(a) ((float*)((a).ws + WS_PART))
__device__ __forceinline__ float wave_sum(float v) {
#pragma unroll
    for (int o = 1; o < 64; o <<= 1) v += __shfl_xor(v, o);
    return v;
}
__device__ __forceinline__ const float* xrow(const Args& A, int m) { return m < MP ? A_XP(A) + (size_t)m * DM : A_XS(A) + (size_t)(m - MP) * DM; }

__device__ __forceinline__ void p0_transpose_item(const float* W, int K, int N, bf16* WT, int dstrow0, int nsrc0, int nvalid, int k0, LAS float* scr, int lane) {
    { f32x4 v[8]; const int n4 = (lane & 7) * 4;
#pragma unroll
      for (int i = 0; i < 8; ++i) { const int kk = 8 * i + (lane >> 3); v[i] = (n4 < nvalid) ? *(const f32x4*)(W + (size_t)(k0 + kk) * N + nsrc0 + n4) : (f32x4){0.f, 0.f, 0.f, 0.f}; }
#pragma unroll
      for (int i = 0; i < 8; ++i) { const int kk = 8 * i + (lane >> 3); LAS float* d = scr + kk * 33 + n4; d[0] = v[i].x; d[1] = v[i].y; d[2] = v[i].z; d[3] = v[i].w; } }
    LDS_WAIT(); asm volatile("" ::: "memory");
    const int c = lane & 7;
#pragma unroll
    for (int j = 0; j < 4; ++j) { const int n = (lane >> 3) + 8 * j; const LAS float* s = scr + (8 * c) * 33 + n;
        v4u o; o.x = pk2(s[0 * 33], s[1 * 33]); o.y = pk2(s[2 * 33], s[3 * 33]); o.z = pk2(s[4 * 33], s[5 * 33]); o.w = pk2(s[6 * 33], s[7 * 33]);
        *(GAS v4u*)(WT + (size_t)(dstrow0 + n) * K + k0 + 8 * c) = o; }
    LDS_WAIT(); asm volatile("" ::: "memory");
}
__device__ __forceinline__ void p0_prologue(Frame& F, const Args& A) {
    LAS float* scr = (LAS float*)(F.lds + F.wave * 16384);
    const int gw = blockIdx.x * NWAVES + F.wave, NGW = F.G * NWAVES;
    constexpr int I_IN = (1024 / 64) * (NINP / 32), I_OUT = (2048 / 64) * (1024 / 32), I_P = 4 * (256 / 64) * (256 / 32);
    f32x4 gp[4];
#pragma unroll
    for (int j = 0; j < 4; ++j) gp[j] = *((const f32x4*)A_GPRE(A) + F.lane + 64 * j);
    f32x4 c0[4], c1[4], n0[4], n1[4];
#define XN_LOAD(d0, d1, mm) do { const int m1_ = (mm) + NGW; const GAS f32x4* p0_ = (const GAS f32x4*)xrow(A, (mm) < M ? (mm) : gw) + F.lane; const GAS f32x4* p1_ = (const GAS f32x4*)xrow(A, m1_ < M ? m1_ : gw) + F.lane; \
        _Pragma("unroll") for (int j = 0; j < 4; ++j) d0[j] = __builtin_nontemporal_load(p0_ + 64 * j); _Pragma("unroll") for (int j = 0; j < 4; ++j) d1[j] = __builtin_nontemporal_load(p1_ + 64 * j); } while (0)
    XN_LOAD(c0, c1, gw);
    for (int it = gw; it < I_IN + I_OUT + I_P; it += NGW) {
        int r = it;
        if (r < I_IN) { const int nblk = NINP / 32, kb = r / nblk, nb = r % nblk, n0 = 32 * nb;
            int src = n0, nvalid = 32;
            if (n0 >= 1024 && n0 < 3072) src = n0 + 1024; else if (n0 >= 3072 && n0 < 4096) src = n0 - 2048;
            if (n0 == 5120) nvalid = 16; else if (n0 > 5120) { nvalid = 0; src = 0; }
            p0_transpose_item(A_WIN(A), 1024, NIN, A_WINT(A), n0, src, nvalid, 64 * kb, scr, F.lane); continue; }
        r -= I_IN;
        if (r < I_OUT) { const int nblk = 1024 / 32, kb = r / nblk, nb = r % nblk; p0_transpose_item(A_WOUT(A), 2048, 1024, A_WOUTT(A), 32 * nb, 32 * nb, 32, 64 * kb, scr, F.lane); continue; }
        r -= I_OUT;
        { const int gq = r / 32, rr = r % 32, kb = rr / 8, nb = rr % 8; p0_transpose_item(A_WPOOL(A) + (size_t)gq * 65536, 256, 256, A_WPT(A), gq * 256 + 32 * nb, 32 * nb, 32, 64 * kb, scr, F.lane); }
    }
    for (int m = gw; m < M; m += 2 * NGW) {
        const int m1 = m + NGW; const bool two = m1 < M;
        XN_LOAD(n0, n1, m + 2 * NGW);
        float s0 = 0.f, s1 = 0.f;
#pragma unroll
        for (int j = 0; j < 4; ++j) { s0 += (c0[j].x * c0[j].x + c0[j].y * c0[j].y) + (c0[j].z * c0[j].z + c0[j].w * c0[j].w); s1 += (c1[j].x * c1[j].x + c1[j].y * c1[j].y) + (c1[j].z * c1[j].z + c1[j].w * c1[j].w); }
        const float r0 = 1.0f / sqrtf(wave_sum(s0) * (1.f / DM) + EPS), r1 = 1.0f / sqrtf(wave_sum(s1) * (1.f / DM) + EPS);
        GAS unsigned long long* o0 = (GAS unsigned long long*)(A_XN(A) + (size_t)m * DM) + F.lane;
#pragma unroll
        for (int j = 0; j < 4; ++j) o0[64 * j] = (unsigned long long)pk2(c0[j].x * r0 * gp[j].x, c0[j].y * r0 * gp[j].y) | ((unsigned long long)pk2(c0[j].z * r0 * gp[j].z, c0[j].w * r0 * gp[j].w) << 32);
        if (two) { GAS unsigned long long* o1 = (GAS unsigned long long*)(A_XN(A) + (size_t)m1 * DM) + F.lane;
#pragma unroll
            for (int j = 0; j < 4; ++j) o1[64 * j] = (unsigned long long)pk2(c1[j].x * r1 * gp[j].x, c1[j].y * r1 * gp[j].y) | ((unsigned long long)pk2(c1[j].z * r1 * gp[j].z, c1[j].w * r1 * gp[j].w) << 32); }
#pragma unroll
        for (int j = 0; j < 4; ++j) { c0[j] = n0[j]; c1[j] = n1[j]; }
    }
#undef XN_LOAD
}

template <int w, int MODE>
__device__ __forceinline__ void poolgen_half(const LAS unsigned char* srow, const float* hist, LAS unsigned char* dA, LAS unsigned char* dB) {
#pragma unroll
    for (int sb = 0; sb < 2; ++sb) {
        unsigned outlo[8];
#pragma unroll
        for (int ep = 0; ep < 2; ++ep) {
            float a[23][2];
#pragma unroll
            for (int i = 0; i < 23; ++i) {
                if (i < 16 - w || (MODE == 1 && 8 * sb + i < 15)) { a[i][0] = 0.f; a[i][1] = 0.f; }
                else if (MODE == 2 && 8 * sb + i < 15) { const f32x2v hv = *(const f32x2v*)(hist + (8 * sb + i) * 1024 + 2 * ep); a[i][0] = hv.x; a[i][1] = hv.y; }
                else { const unsigned wv = *(const LAS unsigned*)(srow + (8 * sb + i) * 512 + 4 * ep); a[i][0] = bflo(wv); a[i][1] = bfhi(wv); } }
            float cur[8][2];
#pragma unroll
            for (int r = 0; r < 8; ++r) { cur[r][0] = a[15 + r][0]; cur[r][1] = a[15 + r][1]; }
#pragma unroll
            for (int i = 22; i >= 1; --i) { a[i][0] += a[i - 1][0]; a[i][1] += a[i - 1][1]; }
            if (w >= 4) {
#pragma unroll
                for (int i = 22; i >= 3; --i) { a[i][0] += a[i - 2][0]; a[i][1] += a[i - 2][1]; } }
            if (w >= 8) {
#pragma unroll
                for (int i = 22; i >= 7; --i) { a[i][0] += a[i - 4][0]; a[i][1] += a[i - 4][1]; } }
            if (w >= 16) {
#pragma unroll
                for (int i = 22; i >= 15; --i) { a[i][0] += a[i - 8][0]; a[i][1] += a[i - 8][1]; } }
#pragma unroll
            for (int r = 0; r < 8; ++r) { const float rc = 1.0f / (float)((MODE == 1 && 8 * sb + r + 1 < w) ? 8 * sb + r + 1 : w);
                const unsigned o = pg8::cvt_pk_bf16(a[15 + r][0] * rc - cur[r][0], a[15 + r][1] * rc - cur[r][1]);
                if (ep == 0) outlo[r] = o; else *(LAS v2u*)((sb ? dB : dA) + r * 64) = (v2u){outlo[r], o}; }
            __builtin_amdgcn_sched_barrier(0);
        }
    }
}
#define OPQ(x) asm volatile("" : "+v"(x))
__device__ __forceinline__ void pool_unit_of(int V, int& R0, int& g) { if (V < 1024) { g = V >> 8; R0 = ((V & 255) >> 1) * 256 + (V & 1) * 128; } else { const int s_ = V - 1024; g = (s_ >> 1) & 3; R0 = (128 + (s_ >> 3)) * 256 + (s_ & 1) * 128; } }
__device__ __forceinline__ void pool_run(Frame& F, const Args& A, int ubeg, int uend) {
    LAS unsigned char* lds = F.lds;
    const int wid = F.wave;
    if (ubeg >= uend) return;
    int R0, g; pool_unit_of(ubeg, R0, g);
    int gB = -1;
#define PU_DMA(R0x, gx) do { int ln_ = F.lane; OPQ(ln_); const char* zb_ = (const char*)A_Z(A) + ((long)((R0x) - 16 + 18 * wid) * LDZ + ZU + (gx) * 256) * 2; \
        const unsigned vo_ = (unsigned)((ln_ >> 5) * (LDZ * 2) + (ln_ & 31) * 16); \
        _Pragma("unroll") for (int q = 0; q < 9; ++q) __builtin_amdgcn_global_load_lds((const unsigned*)(zb_ + vo_ + q * (4 * LDZ)), (LAS unsigned*)(lds + PU_STG + (wid * 9 + q) * 1024), 16, 0, 0); } while (0)
    PU_DMA(R0, g);
    pg8::bf16x8 Bf[2][8];
    for (int nu = 0;; ++nu) {
        int R0n = R0, gn = g; const int un = ubeg + nu + 1; const bool hasn = un < uend; if (hasn) pool_unit_of(un, R0n, gn);
        asm volatile("s_waitcnt vmcnt(0)" ::: "memory"); __syncthreads();
        int lane = F.lane; OPQ(lane);
        const int fr = lane & 15, fq = lane >> 4;
        bf16* base = A_Z(A) + (size_t)(R0 + fr) * LDZ + ZGP + g * 256 + wid * 32 + 8 * fq;
        v4u gs[8];
#pragma unroll
        for (int m = 0; m < 8; ++m) gs[m] = *(const v4u*)(base + (size_t)(16 * m) * LDZ);
        const bf16* wb = A_WPT(A) + (size_t)(g * 256 + wid * 32 + 8 * (fr >> 2) + (fr & 3)) * 256 + 8 * fq;
        if (g != gB) { gB = g;
#pragma unroll
            for (int n = 0; n < 2; ++n)
#pragma unroll
                for (int kk = 0; kk < 8; ++kk) Bf[n][kk] = *(const pg8::bf16x8*)(wb + (4 * n) * 256 + 32 * kk); }
        __builtin_amdgcn_sched_barrier(0);
        { int ln = F.lane; OPQ(ln);
          const int row0 = R0 + wid * 16; const bool samp = row0 >= MP;
          int b, ts; if (!samp) { b = row0 / TP; ts = row0 % TP; } else { b = (row0 - MP) / TS; ts = (row0 - MP) % TS; }
          const int w = 2 << g, c0 = g * 256 + 4 * ln;
          LAS unsigned char* dA = lds + (ln >> 4) * 16384 + (wid * 2 + ((ln >> 3) & 1)) * 1024 + 8 * (ln & 7);
          LAS unsigned char* dB = lds + (ln >> 4) * 16384 + (wid * 2 + ((ln >> 3) & 1)) * 1024 + 512 + ((8 * (ln & 7)) ^ 32);
          const LAS unsigned char* srow = lds + PU_STG + (16 * wid + 1) * 512 + 8 * ln;
          const float* hist = A_SPOOL(A) + (size_t)b * 15 * 1024 + c0;
          const int mode = ts >= 15 ? 0 : (samp ? 2 : 1);
#define PU_GEN(W) do { if (mode == 0) poolgen_half<W, 0>(srow, hist, dA, dB); else if (mode == 1) poolgen_half<W, 1>(srow, hist, dA, dB); else poolgen_half<W, 2>(srow, hist, dA, dB); } while (0)
          if (w == 2) PU_GEN(2); else if (w == 4) PU_GEN(4); else if (w == 8) PU_GEN(8); else PU_GEN(16);
#undef PU_GEN
        }
        __builtin_amdgcn_sched_barrier(0);
#pragma unroll
        for (int m = 0; m < 8; ++m) asm volatile("" : "+v"(gs[m]));
#pragma unroll
        for (int n = 0; n < 2; ++n)
#pragma unroll
            for (int kk = 0; kk < 8; ++kk) asm volatile("" : "+v"(Bf[n][kk]));
        f32x4 acc[8][2];
#pragma unroll
        for (int m = 0; m < 8; ++m)
#pragma unroll
            for (int n = 0; n < 2; ++n) acc[m][n] = (f32x4){0.f, 0.f, 0.f, 0.f};
        LDS_WAIT(); asm volatile("" ::: "memory");
        __builtin_amdgcn_s_barrier();
        asm volatile("" ::: "memory");
        PU_DMA(R0n, gn);
        __builtin_amdgcn_sched_barrier(0);
        const int aoff = pg8::lds_byte(fr, fq * 8);
#pragma unroll
        for (int t = 0; t < 4; ++t)
#pragma unroll
            for (int mh = 0; mh < 2; ++mh) {
                pg8::bf16x8 At[4][2];
#pragma unroll
                for (int m = 0; m < 4; ++m)
#pragma unroll
                    for (int kk = 0; kk < 2; ++kk) At[m][kk] = *(const LAS pg8::bf16x8*)(lds + t * 16384 + aoff + (4 * mh + m) * 2048 + kk * 1024);
#pragma unroll
                for (int m = 0; m < 4; ++m)
#pragma unroll
                    for (int n = 0; n < 2; ++n)
#pragma unroll
                        for (int kk = 0; kk < 2; ++kk) acc[4 * mh + m][n] = __builtin_amdgcn_mfma_f32_16x16x32_bf16(Bf[n][2 * t + kk], At[m][kk], acc[4 * mh + m][n], 0, 0, 0);
            }
#pragma unroll
        for (int m = 0; m < 8; ++m) { const v4u gsg = gs[m];
            const f32x4 v0 = acc[m][0] * (f32x4){bflo(gsg.x), bfhi(gsg.x), bflo(gsg.y), bfhi(gsg.y)}, v1 = acc[m][1] * (f32x4){bflo(gsg.z), bfhi(gsg.z), bflo(gsg.w), bfhi(gsg.w)};
            v4u o; o.x = pg8::cvt_pk_bf16(v0[0], v0[1]); o.y = pg8::cvt_pk_bf16(v0[2], v0[3]); o.z = pg8::cvt_pk_bf16(v1[0], v1[1]); o.w = pg8::cvt_pk_bf16(v1[2], v1[3]);
            *(v4u*)(base + (size_t)(16 * m) * LDZ) = o; }
        if (!hasn) break;
        R0 = R0n; g = gn;
    }
#undef PU_DMA
    asm volatile("s_waitcnt vmcnt(0)" ::: "memory"); __syncthreads();
}
__device__ __forceinline__ void newpool_copy(Frame& F, const Args& A) {
    const int gw = blockIdx.x * NWAVES + F.wave, NGW = F.G * NWAVES;
    for (int r = gw; r < 32 * 15; r += NGW) { const int s = r / 15, i = r % 15;
        const int src = s < 16 ? s * TP + (TP - 15) + i : MP + (s - 16) * TS + (TS - 15) + i;
        float* dst = A.out + (s < 16 ? O_NPP + (size_t)(s * 15 + i) * 1024 : O_NPS + (size_t)((s - 16) * 15 + i) * 1024);
        const bf16* sp = A_Z(A) + (size_t)src * LDZ + ZU;
#pragma unroll
        for (int j = 0; j < 2; ++j) { const int c = 8 * F.lane + 512 * j; const v4u w4 = *(const v4u*)(sp + c);
            *(f32x4*)(dst + c) = (f32x4){bflo(w4.x), bfhi(w4.x), bflo(w4.y), bfhi(w4.y)}; *(f32x4*)(dst + c + 4) = (f32x4){bflo(w4.z), bfhi(w4.z), bflo(w4.w), bfhi(w4.w)}; }
    }
}

constexpr int GL_GLRB = 0, GL_WGT = 2048, GL_BIAS = 6144, GL_GTOT = 6656, GL_DEXP = 7680, GL_PART = 8192, GL_GG = 10240, GL_QT = 11264, GL_KT = 28672, GL_OI = GL_QT, GL_VT = 46080, GL_VR = 82944, GL_KDT = GL_VR, GL_PP = GL_VR + 18432, GL_END = GL_VR + 33792;
static_assert(GL_END <= 131072 && GL_PP + 9216 <= GL_END && GL_OI + 64 * 264 * 2 <= GL_VT, "GLA LDS map");
template <bool SO>
__device__ __forceinline__ void gla_unit(Frame& F, const Args& A, int row0, int nchunk, int h, int nprev, const float* sprev, const float* bprev, bool raws, float* Sout, float* Bout) {
    LAS unsigned char* lds = F.lds;
    LAS unsigned char* GLRB = lds + GL_GLRB; LAS unsigned char* WGT = lds + GL_WGT; LAS float* BIAS = (LAS float*)(lds + GL_BIAS); LAS float* GTOT = (LAS float*)(lds + GL_GTOT);
    LAS float* DEXP = (LAS float*)(lds + GL_DEXP); LAS float* PART = (LAS float*)(lds + GL_PART); LAS float* GG = (LAS float*)(lds + GL_GG);
    LAS unsigned char* QT = lds + GL_QT; LAS unsigned char* KT = lds + GL_KT; LAS unsigned char* OI = lds + GL_OI; LAS unsigned char* KDT = lds + GL_KDT; LAS unsigned char* VT = lds + GL_VT; LAS unsigned char* PP = lds + GL_PP; LAS unsigned char* VR = lds + GL_VR;
    const int wid = F.wave;
    const bf16* Z = A_Z(A);
    { const int tid = F.tid, k = tid & 127, r4 = tid >> 7; const float* wp = A_WGU(A) + (size_t)(4 * r4) * 512 + h * 128 + k;
      *(LAS v2u*)(WGT + (k * 16 + 4 * r4) * 2) = (v2u){pk2(wp[0], wp[512]), pk2(wp[1024], wp[1536])};
      if (tid < 128) BIAS[tid] = A_BGU(A)[h * 128 + tid];
      if (tid < 256) GG[tid] = A_GGO(A)[tid]; }
    f32x16 S[4];
#pragma unroll
    for (int kb = 0; kb < 4; ++kb)
#pragma unroll
        for (int r = 0; r < 16; ++r) S[kb][r] = 0.f;
    for (int p = 0; p < nprev; ++p) { int ln = F.lane; OPQ(ln); const int hh = ln >> 5, l31 = ln & 31; const float* sp = sprev + (size_t)p * 32768; const float* bp = bprev + (size_t)p * 128;
        if (raws) {
#pragma unroll
            for (int kb = 0; kb < 4; ++kb)
#pragma unroll
                for (int r = 0; r < 16; ++r) { const int k = 32 * kb + (r & 3) + 8 * (r >> 2) + 4 * hh; S[kb][r] = sp[(size_t)k * 256 + 32 * wid + l31]; }
        } else {
#pragma unroll
            for (int kb = 0; kb < 4; ++kb)
#pragma unroll
                for (int g = 0; g < 4; ++g) { const f32x4 sv = *(const f32x4*)(sp + (size_t)(((wid * 4 + kb) * 4 + g) * 64 + ln) * 4); const f32x4 bv = *(const f32x4*)(bp + 32 * kb + 8 * g + 4 * hh);
                    S[kb][4 * g + 0] = S[kb][4 * g + 0] * __expf(bv.x) + sv.x; S[kb][4 * g + 1] = S[kb][4 * g + 1] * __expf(bv.y) + sv.y; S[kb][4 * g + 2] = S[kb][4 * g + 2] * __expf(bv.z) + sv.z; S[kb][4 * g + 3] = S[kb][4 * g + 3] * __expf(bv.w) + sv.w; }
        } }
    float bsum = 0.f;
    v4u rq[2], rk[2], rv[4], rg;
#define GLA_LOAD_RAW(zbase) do { int t_ = F.tid; OPQ(t_); \
        _Pragma("unroll") for (int i = 0; i < 2; ++i) { const int idx = t_ + 512 * i, row = idx >> 4, c8 = idx & 15; const unsigned off = (unsigned)((row * LDZ + ZQ + h * 128 + 8 * c8) * 2); if constexpr (!SO) rq[i] = *(const v4u*)((zbase) + off); rk[i] = *(const v4u*)((zbase) + off + (ZK - ZQ) * 2); } \
        _Pragma("unroll") for (int i = 0; i < 4; ++i) { const int idx = t_ + 512 * i, row = idx >> 5, c8 = idx & 31; rv[i] = *(const v4u*)((zbase) + (unsigned)((row * LDZ + ZV + h * 256 + 8 * c8) * 2)); } \
        if (t_ < 128) rg = *(const v4u*)((zbase) + (unsigned)(((t_ >> 1) * LDZ + ZLR + 8 * (t_ & 1)) * 2)); } while (0)
#define GLA_LOAD_QK(zbase) do { int t_ = F.tid; OPQ(t_); \
        _Pragma("unroll") for (int i = 0; i < 2; ++i) { const int idx = t_ + 512 * i, row = idx >> 4, c8 = idx & 15; const unsigned off = (unsigned)((row * LDZ + ZQ + h * 128 + 8 * c8) * 2); if constexpr (!SO) rq[i] = *(const v4u*)((zbase) + off); rk[i] = *(const v4u*)((zbase) + off + (ZK - ZQ) * 2); } \
        if (t_ < 128) rg = *(const v4u*)((zbase) + (unsigned)(((t_ >> 1) * LDZ + ZLR + 8 * (t_ & 1)) * 2)); } while (0)
#define GLA_LD_K(i, zbase) do { int t_ = F.tid; OPQ(t_); const int idx = t_ + 512 * (i), row = idx >> 4, c8 = idx & 15; __builtin_amdgcn_sched_barrier(0); rk[i] = *(const v4u*)((zbase) + (unsigned)((row * LDZ + ZK + h * 128 + 8 * c8) * 2)); __builtin_amdgcn_sched_barrier(0); } while (0)
#define GLA_LD_Q(i, zbase) do { int t_ = F.tid; OPQ(t_); const int idx = t_ + 512 * (i), row = idx >> 4, c8 = idx & 15; __builtin_amdgcn_sched_barrier(0); rq[i] = *(const v4u*)((zbase) + (unsigned)((row * LDZ + ZQ + h * 128 + 8 * c8) * 2)); __builtin_amdgcn_sched_barrier(0); } while (0)
#define GLA_LD_G(zbase) do { int t_ = F.tid; OPQ(t_); __builtin_amdgcn_sched_barrier(0); if (t_ < 128) rg = *(const v4u*)((zbase) + (unsigned)(((t_ >> 1) * LDZ + ZLR + 8 * (t_ & 1)) * 2)); __builtin_amdgcn_sched_barrier(0); } while (0)
#define GLA_LD_V(i, zbase) do { int t_ = F.tid; OPQ(t_); const int idx = t_ + 512 * (i), row = idx >> 5, c8 = idx & 31; __builtin_amdgcn_sched_barrier(0); rv[i] = *(const v4u*)((zbase) + (unsigned)((row * LDZ + ZV + h * 256 + 8 * c8) * 2)); __builtin_amdgcn_sched_barrier(0); } while (0)
#define GLA_LD_S(n, zbase) do { int t_ = F.tid; OPQ(t_); const int idx = t_ + 512 * (n), row = idx >> 5, c8 = idx & 31; __builtin_amdgcn_sched_barrier(0); sgv[n] = *(const v4u*)((zbase) + (unsigned)((row * LDZ + ZGG + h * 256 + 8 * c8) * 2)); __builtin_amdgcn_sched_barrier(0); } while (0)
#define GLA_LOAD_V(zbase) do { int t_ = F.tid; OPQ(t_); \
        _Pragma("unroll") for (int i = 0; i < 4; ++i) { const int idx = t_ + 512 * i, row = idx >> 5, c8 = idx & 31; rv[i] = *(const v4u*)((zbase) + (unsigned)((row * LDZ + ZV + h * 256 + 8 * c8) * 2)); } } while (0)
    { const char* z0 = (const char*)Z + (size_t)row0 * (LDZ * 2); GLA_LOAD_RAW(z0); }
    __syncthreads();

    for (int c = 0; c < nchunk; ++c) {
        const char* zc = (const char*)Z + (size_t)(row0 + 64 * c) * (LDZ * 2);
        { int tid = F.tid; OPQ(tid);
#pragma unroll
          for (int i = 0; i < 2; ++i) { const int idx = tid + 512 * i, row = idx >> 4, c8 = idx & 15; if constexpr (!SO) *(LAS v4u*)(QT + (row * 136 + 8 * c8) * 2) = rq[i]; *(LAS v4u*)(KT + (row * 136 + 8 * c8) * 2) = rk[i]; }
#pragma unroll
          for (int i = 0; i < 4; ++i) { const int idx = tid + 512 * i, row = idx >> 5, c8 = idx & 31; *(LAS v4u*)(VR + (row * 264 + 8 * c8) * 2) = rv[i]; }
          if (tid < 128) *(LAS v4u*)(GLRB + tid * 16) = rg; }
        __syncthreads();
        const bool nx = c + 1 < nchunk; const char* zn = zc + (size_t)64 * (LDZ * 2);
        if (nx) GLA_LD_G(zn);
        v4u sgv[4];
        { int tid = F.tid; OPQ(tid); const int vv = tid & 255, jh = tid >> 8;
#pragma unroll
          for (int q = 0; q < 4; ++q) { unsigned e[8];
#pragma unroll
              for (int x = 0; x < 8; ++x) e[x] = *(const LAS unsigned short*)(VR + ((32 * jh + 8 * q + x) * 264 + vv) * 2);
              *(LAS v4u*)(VT + (vv * 72 + 32 * jh + 8 * q) * 2) = (v4u){e[0] | (e[1] << 16), e[2] | (e[3] << 16), e[4] | (e[5] << 16), e[6] | (e[7] << 16)}; } }
        float pb[16];
        { int lane = F.lane; OPQ(lane); const int hh = lane >> 5, l31 = lane & 31; const int kb = wid & 3, jb = wid >> 2, k = 32 * kb + l31;
          const bf16x8 ga = *(const LAS bf16x8*)(GLRB + ((32 * jb + l31) * 16 + 8 * hh) * 2);
          const bf16x8 wb = *(const LAS bf16x8*)(WGT + (k * 16 + 8 * hh) * 2);
          f32x16 d;
#pragma unroll
          for (int r = 0; r < 16; ++r) d[r] = 0.f;
          d = __builtin_amdgcn_mfma_f32_32x32x16_bf16(ga, wb, d, 0, 0, 0);
          const float bias = BIAS[k];
          float gs[4], pgs[4];
#pragma unroll
          for (int g = 0; g < 4; ++g) { float run = 0.f;
              if (nx) { if (g == 0) GLA_LD_K(0, zn); else if (g == 1) GLA_LD_K(1, zn); else if constexpr (!SO) { if (g == 2) GLA_LD_Q(0, zn); else GLA_LD_Q(1, zn); } }
#pragma unroll
              for (int e = 0; e < 4; ++e) { const float a = d[4 * g + e] + bias; const float la = (fminf(a, 0.f) - __logf(1.0f + __expf(-fabsf(a)))) * (1.0f / 16.0f); run += la; pb[4 * g + e] = run; }
              gs[g] = run; }
#pragma unroll
          for (int g = 0; g < 4; ++g) pgs[g] = __shfl_xor(gs[g], 32);
          float offs = 0.f;
#pragma unroll
          for (int g = 0; g < 4; ++g) { const float mine = offs + (hh ? pgs[g] : 0.f);
#pragma unroll
              for (int e = 0; e < 4; ++e) pb[4 * g + e] += mine;
              offs += gs[g] + pgs[g]; }
          if (hh == 0) GTOT[jb * 128 + k] = offs; }
        __syncthreads();
        { int lane = F.lane; OPQ(lane); const int hh = lane >> 5, l31 = lane & 31; const int kb = wid & 3, jb = wid >> 2, k = 32 * kb + l31;
          const float t0 = GTOT[k], t1 = GTOT[128 + k]; const float bend = t0 + t1, joff = jb ? t0 : 0.f; const float ebend = __expf(bend);
          bsum += bend;
#pragma unroll
          for (int g = 0; g < 4; ++g) { float kdv[4];
              if (nx) { if (g == 0) GLA_LD_V(0, zn); else if (g == 1) GLA_LD_V(1, zn); else if (g == 2) GLA_LD_V(2, zn); else GLA_LD_V(3, zn); }
#pragma unroll
              for (int e = 0; e < 4; ++e) { const int j = 32 * jb + 8 * g + 4 * hh + e; const float b = pb[4 * g + e] + joff;
                  LAS unsigned short* kp = (LAS unsigned short*)(KT + (j * 136 + k) * 2); const float kk = bf2f(*kp);
                  if constexpr (!SO) { LAS unsigned short* qp = (LAS unsigned short*)(QT + (j * 136 + k) * 2); const float q = bf2f(*qp);
                      const float qt = q * __expf(b), kt = kk * __expf(-b); kdv[e] = kt * ebend;
                      const unsigned w = pg8::cvt_pk_bf16(qt, kt); *qp = (unsigned short)w; *kp = (unsigned short)(w >> 16); }
                  else kdv[e] = kk * __expf(bend - b); }
              *(LAS v2u*)(KDT + (k * 72 + 32 * jb + 8 * g + 4 * hh) * 2) = (v2u){pg8::cvt_pk_bf16(kdv[0], kdv[1]), pg8::cvt_pk_bf16(kdv[2], kdv[3])}; }
          if (jb == 0 && hh == 0) DEXP[k] = ebend; }
        __syncthreads();
        f32x16 o[2];
        if constexpr (!SO) {
        if (wid < 3) { int lane = F.lane; OPQ(lane); const int hh = lane >> 5, l31 = lane & 31;
            const int jb = (wid == 2) ? 1 : 0, ib = (wid >= 1) ? 1 : 0;
            f32x16 sc;
#pragma unroll
            for (int r = 0; r < 16; ++r) sc[r] = 0.f;
#pragma unroll
            for (int s = 0; s < 8; ++s) { const bf16x8 a = *(const LAS bf16x8*)(KT + ((32 * jb + l31) * 136 + 16 * s + 8 * hh) * 2); const bf16x8 bq = *(const LAS bf16x8*)(QT + ((32 * ib + l31) * 136 + 16 * s + 8 * hh) * 2);
                sc = __builtin_amdgcn_mfma_f32_32x32x16_bf16(a, bq, sc, 0, 0, 0); }
            const int i = 32 * ib + l31;
#pragma unroll
            for (int g = 0; g < 4; ++g) { const int j0 = 32 * jb + 8 * g + 4 * hh; float v[4];
#pragma unroll
                for (int e = 0; e < 4; ++e) v[e] = (i >= j0 + e) ? sc[4 * g + e] : 0.f;
                *(LAS v2u*)(PP + (i * 72 + j0) * 2) = (v2u){pg8::cvt_pk_bf16(v[0], v[1]), pg8::cvt_pk_bf16(v[2], v[3])}; } }
        { int lane = F.lane; OPQ(lane); const int hh = lane >> 5, l31 = lane & 31;
#pragma unroll
          for (int ib = 0; ib < 2; ++ib)
#pragma unroll
            for (int r = 0; r < 16; ++r) o[ib][r] = 0.f;
#pragma unroll
          for (int kb = 0; kb < 4; ++kb) {
            if (kb == 0) GLA_LD_S(0, zc); else if (kb == 1) GLA_LD_S(1, zc); else if (kb == 2) GLA_LD_S(2, zc); else GLA_LD_S(3, zc);
#pragma unroll
            for (int s = 0; s < 2; ++s) {
                v4u af; af.x = pg8::cvt_pk_bf16(S[kb][8 * s + 0], S[kb][8 * s + 1]); af.y = pg8::cvt_pk_bf16(S[kb][8 * s + 2], S[kb][8 * s + 3]); af.z = pg8::cvt_pk_bf16(S[kb][8 * s + 4], S[kb][8 * s + 5]); af.w = pg8::cvt_pk_bf16(S[kb][8 * s + 6], S[kb][8 * s + 7]);
                const bf16x8 a = __builtin_bit_cast(bf16x8, af);
#pragma unroll
                for (int ib = 0; ib < 2; ++ib) { const LAS unsigned char* qp = QT + ((32 * ib + l31) * 136 + 32 * kb + 16 * s + 4 * hh) * 2;
                    const v2u lo = *(const LAS v2u*)qp, hi = *(const LAS v2u*)(qp + 16);
                    const bf16x8 bq = __builtin_bit_cast(bf16x8, ((v4u){lo.x, lo.y, hi.x, hi.y}));
                    o[ib] = __builtin_amdgcn_mfma_f32_32x32x16_bf16(a, bq, o[ib], 0, 0, 0); } } } }
        __syncthreads();
        { int lane = F.lane; OPQ(lane); const int hh = lane >> 5, l31 = lane & 31;
#pragma unroll
          for (int s = 0; s < 4; ++s) { const bf16x8 a = *(const LAS bf16x8*)(VT + ((32 * wid + l31) * 72 + 16 * s + 8 * hh) * 2);
            if (s < 2) { const bf16x8 b0 = *(const LAS bf16x8*)(PP + (l31 * 72 + 16 * s + 8 * hh) * 2); o[0] = __builtin_amdgcn_mfma_f32_32x32x16_bf16(a, b0, o[0], 0, 0, 0); }
            const bf16x8 b1 = *(const LAS bf16x8*)(PP + ((32 + l31) * 72 + 16 * s + 8 * hh) * 2); o[1] = __builtin_amdgcn_mfma_f32_32x32x16_bf16(a, b1, o[1], 0, 0, 0); }
#pragma unroll
          for (int ib = 0; ib < 2; ++ib) { float ss = 0.f;
#pragma unroll
            for (int r = 0; r < 16; ++r) ss += o[ib][r] * o[ib][r];
            ss += __shfl_xor(ss, 32);
            if (hh == 0) PART[wid * 64 + 32 * ib + l31] = ss; } }
        }
        { int lane = F.lane; OPQ(lane); const int hh = lane >> 5, l31 = lane & 31;
#pragma unroll
          for (int kb = 0; kb < 4; ++kb) {
#pragma unroll
            for (int g = 0; g < 4; ++g) { const f32x4 d4 = *(const LAS f32x4*)(DEXP + 32 * kb + 8 * g + 4 * hh);
                S[kb][4 * g + 0] *= d4.x; S[kb][4 * g + 1] *= d4.y; S[kb][4 * g + 2] *= d4.z; S[kb][4 * g + 3] *= d4.w; }
#pragma unroll
            for (int s = 0; s < 4; ++s) { const bf16x8 a = *(const LAS bf16x8*)(KDT + ((32 * kb + l31) * 72 + 16 * s + 8 * hh) * 2); const bf16x8 bv = *(const LAS bf16x8*)(VT + ((32 * wid + l31) * 72 + 16 * s + 8 * hh) * 2);
                S[kb] = __builtin_amdgcn_mfma_f32_32x32x16_bf16(a, bv, S[kb], 0, 0, 0); } } }
        if constexpr (!SO) {
        __syncthreads();
        { int lane = F.lane; OPQ(lane); const int hh = lane >> 5, l31 = lane & 31;
#pragma unroll
          for (int ib = 0; ib < 2; ++ib) { float tot = 0.f;
#pragma unroll
            for (int w8 = 0; w8 < 8; ++w8) tot += PART[w8 * 64 + 32 * ib + l31];
            const float rinv = __builtin_amdgcn_rsqf(tot * (1.0f / 256.0f) + EPS);
#pragma unroll
            for (int g = 0; g < 4; ++g) { const f32x4 g4 = *(const LAS f32x4*)(GG + 32 * wid + 8 * g + 4 * hh);
                *(LAS v2u*)(OI + ((32 * ib + l31) * 264 + 32 * wid + 8 * g + 4 * hh) * 2) = (v2u){pg8::cvt_pk_bf16(o[ib][4 * g + 0] * rinv * g4.x, o[ib][4 * g + 1] * rinv * g4.y), pg8::cvt_pk_bf16(o[ib][4 * g + 2] * rinv * g4.z, o[ib][4 * g + 3] * rinv * g4.w)}; } } }
        __syncthreads();
        { int tid = F.tid; OPQ(tid);
#pragma unroll
          for (int n = 0; n < 4; ++n) { const int idx = tid + 512 * n, row = idx >> 5, c8 = idx & 31; const v4u ov = *(const LAS v4u*)(OI + (row * 264 + 8 * c8) * 2); const v4u gv = sgv[n];
              v4u y; y.x = pg8::cvt_pk_bf16(bflo(ov.x) * bflo(gv.x), bfhi(ov.x) * bfhi(gv.x)); y.y = pg8::cvt_pk_bf16(bflo(ov.y) * bflo(gv.y), bfhi(ov.y) * bfhi(gv.y));
              y.z = pg8::cvt_pk_bf16(bflo(ov.z) * bflo(gv.z), bfhi(ov.z) * bfhi(gv.z)); y.w = pg8::cvt_pk_bf16(bflo(ov.w) * bflo(gv.w), bfhi(ov.w) * bfhi(gv.w));
              *(v4u*)((char*)zc + (unsigned)((row * LDZ + ZGG + h * 256 + 8 * c8) * 2)) = y; } }
        }
        __syncthreads();
    }
#undef GLA_LOAD_RAW
#undef GLA_LOAD_QK
#undef GLA_LOAD_V
#undef GLA_LD_K
#undef GLA_LD_Q
#undef GLA_LD_G
#undef GLA_LD_V
#undef GLA_LD_S
    if (Sout) { int ln = F.lane; OPQ(ln); const int hh = ln >> 5, l31 = ln & 31;
      if constexpr (SO) {
#pragma unroll
        for (int kb = 0; kb < 4; ++kb)
#pragma unroll
          for (int g = 0; g < 4; ++g) *(f32x4*)(Sout + (size_t)(((wid * 4 + kb) * 4 + g) * 64 + ln) * 4) = (f32x4){S[kb][4 * g + 0], S[kb][4 * g + 1], S[kb][4 * g + 2], S[kb][4 * g + 3]};
      } else {
#pragma unroll
        for (int kb = 0; kb < 4; ++kb)
#pragma unroll
          for (int r = 0; r < 16; ++r) { const int k = 32 * kb + (r & 3) + 8 * (r >> 2) + 4 * hh; Sout[(size_t)k * 256 + 32 * wid + l31] = S[kb][r]; } } }
    if (Bout && wid < 4 && F.lane < 32) Bout[32 * wid + F.lane] = bsum;
    __syncthreads();
}

__global__ void __launch_bounds__(NWAVES * 64, 2) mk_fwd(Args A) {
    extern __shared__ __attribute__((aligned(16))) unsigned char lds[];
    Frame F;
    F.lds = (LAS unsigned char*)lds;
    F.tid = threadIdx.x; F.lane = F.tid & 63; F.wave = __builtin_amdgcn_readfirstlane(F.tid >> 6); F.G = gridDim.x;
#define REFRESH_F() do { int t_ = threadIdx.x; OPQ(t_); F.tid = t_; F.lane = t_ & 63; } while (0)
    const int lo = A.ph_lo, hi = A.ph_hi;
#ifndef PHASE_MASK
#define PHASE_MASK 63
#endif
#ifndef REPEAT_MASK
#define REPEAT_MASK 0
#endif
#define REP(k) (((REPEAT_MASK >> (k)) & 1) ? 2 : 1)
#define IN(k) (((PHASE_MASK >> (k)) & 1) && lo <= (k) && (k) < hi)
#define BOTH(k) (IN(k) && IN((k) + 1))
#if MK_N_LAUNCHES == 1
    for (int u = F.tid; u < (LDS_BYTES - LDSCTL_OFF) / 4; u += NWAVES * 64) ((LAS unsigned*)(F.lds + LDSCTL_OFF))[u] = 0u;
    __syncthreads();
    const XcdBarrier bar = xcd_barrier_post((unsigned*)(A.ws + WS_CTL) + CW_BAR, (volatile LAS unsigned*)(F.lds + MISC_OFF) + 8);
#define GRID_BAR0() xcd_barrier(bar)
#define GRID_BAR() xcd_barrier(bar)
#else
#define GRID_BAR0() do {} while (0)
#define GRID_BAR() do {} while (0)
#endif
    if (IN(0)) { for (int rep = 0; rep < REP(0); ++rep) p0_prologue(F, A); if (BOTH(0)) GRID_BAR0(); }
    if (IN(1)) for (int rep = 0; rep < REP(1); ++rep) {
        pg8::Gemm g{A_XN(A), A_WINT(A), DM, DM, DM, 0}; pg8::StaticOrder S; S.init(NM, NINP / 256, F.G, (int)blockIdx.x);
        EpiZ E{A_Z(A), A_PSCALE(A)};
        pg8::gemm_phase<EpiZ, pg8::StaticOrder, true>(F.lds, g, S, E);
        REFRESH_F();
        if (BOTH(1)) GRID_BAR();
    }
    if (IN(3)) {
        float* SLOC = (float*)(A.ws + WS_SLOC); float* BSEG = (float*)(A.ws + WS_BSEG);
        newpool_copy(F, A);
        const int G = F.G, blk = (int)blockIdx.x;
        const bool pool_first = blk < 192 && (blk & 1);
#define P3A_GLA() do { for (int u = blk; u < 256; u += G) { \
                if (u < 192) { const int b = u / 12, h = (u % 12) / 3, seg = u % 3; \
                    gla_unit<true>(F, A, b * TP + seg * 512, 8, h, 0, nullptr, nullptr, false, SLOC + (size_t)u * 32768, BSEG + (size_t)u * 128); } \
                else { const int us = u - 192, b = us >> 2, h = us & 3; \
                    gla_unit<false>(F, A, MP + b * TS, 1, h, 1, A_SGLA(A) + (size_t)us * 32768, A_BGU(A), true, A.out + O_NGS + (size_t)us * 32768, nullptr); } } } while (0)
#define P3A_POOL() do { int ub, ue; if (blk < 192) { ub = (blk >> 6) * 256 + (blk & 63) * 4; ue = ub + 4; } else { const int k = blk - 192; if (k < 56) { ub = 768 + (k < 32 ? 5 * k : 160 + 4 * (k - 32)); ue = ub + (k < 32 ? 5 : 4); } else { ub = 1024 + 4 * (k - 56); ue = ub + 4; } } \
            if (G == 256) pool_run(F, A, ub, ue); else if (blk == 0) pool_run(F, A, 0, NM * 8); REFRESH_F(); } while (0)
        if (pool_first) { P3A_POOL(); P3A_GLA(); } else { P3A_GLA(); P3A_POOL(); }
#undef P3A_GLA
#undef P3A_POOL
        REFRESH_F();
        GRID_BAR();
        if ((blk & 3) == 0) {
            const int q = blk >> 2, ks = q & 3;
            pg8::Gemm g{A_Z(A) + ZGP + 512 * ks, A_WOUTT(A) + 512 * ks, LDZ, 2048, 512, 0}; OneUnit S1{128 + (q >> 4), (q >> 2) & 3};
            EpiSlab E{(float*)(A.ws + WS_SLAB) + (size_t)q * 65536};
            pg8::gemm_phase<EpiSlab, OneUnit, true>(F.lds, g, S1, E); REFRESH_F(); }
        for (int u = blk; u < 256; u += G) { const int b = u >> 4, h = (u >> 2) & 3, seg = u & 3; const int sl = (b * 4 + h) * 3;
            gla_unit<false>(F, A, b * TP + seg * 512, 8, h, seg, SLOC + (size_t)sl * 32768, BSEG + (size_t)sl * 128, false, seg == 3 ? A.out + O_NGP + (size_t)(b * 4 + h) * 32768 : nullptr, nullptr); }
        if (BOTH(3)) GRID_BAR();
    }
    if (IN(4)) {
        { const int gw = blockIdx.x * NWAVES + F.wave;
          if (gw < MS) { const int r = gw, pnl = r >> 8, rt = r & 255; const float* slab = (const float*)(A.ws + WS_SLAB);
            f32x4 raw[4]; float s2 = 0.f;
#pragma unroll
            for (int pn = 0; pn < 4; ++pn) { f32x4 a = (f32x4){0.f, 0.f, 0.f, 0.f};
#pragma unroll
                for (int ks = 0; ks < 4; ++ks) a = a + *(const f32x4*)(slab + (size_t)(((pnl * 4 + pn) * 4 + ks)) * 65536 + rt * 256 + 4 * F.lane);
                raw[pn] = a; s2 += (a.x * a.x + a.y * a.y) + (a.z * a.z + a.w * a.w); }
            const float rinv = 1.0f / sqrtf(wave_sum(s2) * (1.f / DM) + EPS);
#pragma unroll
            for (int pn = 0; pn < 4; ++pn) { const int c = pn * 256 + 4 * F.lane; const f32x4 xv = *(const f32x4*)(A_XS(A) + (size_t)r * DM + c), gp = *(const f32x4*)(A_GPOST(A) + c);
                *(f32x4*)(A.out + (size_t)(MP + r) * DM + c) = xv + raw[pn] * rinv * gp; } } }
        pg8::Gemm g{A_Z(A) + ZGP, A_WOUTT(A), LDZ, 2048, 2048, 0}; PanelOrder S{(int)blockIdx.x, 128};
        EpiRmsRes E{A_XP(A), A_XS(A), A_GPOST(A), A.out, A_PART(A), (unsigned*)(A.ws + WS_CTL) + CW_CNT, F.lds};
        pg8::gemm_phase<EpiRmsRes, PanelOrder, true>(F.lds, g, S, E);
    }
#undef IN
#undef BOTH
}

extern "C" void kernel_launch(void* const* d_in, const int* in_sizes, int n_in, void* d_out, int out_size, void* d_ws, size_t ws_size, hipStream_t stream) {
    static int grid = 0;
    if (grid == 0) {
        if (n_in != 13 || in_sizes[0] != MP * DM || (size_t)out_size != O_END || ws_size < WS_END) {
            fprintf(stderr, "kernel_launch: unexpected shapes: n_in %d in0 %d out %d ws %zu (need %zu)\n", n_in, n_in > 0 ? in_sizes[0] : -1, out_size, ws_size, (size_t)WS_END); grid = -1; return; }
        int dev = 0, cus = 0, per_cu = 0;
        if (hipGetDevice(&dev) != hipSuccess || hipDeviceGetAttribute(&cus, hipDeviceAttributeMultiprocessorCount, dev) != hipSuccess) { grid = -1; return; }
        if (hipFuncSetAttribute((const void*)mk_fwd, hipFuncAttributeMaxDynamicSharedMemorySize, LDS_BYTES) != hipSuccess) { fprintf(stderr, "kernel_launch: hipFuncSetAttribute failed\n"); grid = -1; return; }
        if (hipOccupancyMaxActiveBlocksPerMultiprocessor(&per_cu, (const void*)mk_fwd, NWAVES * 64, LDS_BYTES) != hipSuccess || per_cu < 1) { fprintf(stderr, "kernel_launch: occupancy query failed (%d)\n", per_cu); (void)hipGetLastError(); grid = -1; return; }
        if (cus != 256) { fprintf(stderr, "kernel_launch: built for a 256-CU device (got %d)\n", cus); grid = -1; return; }
        grid = cus;
    }
    if (grid < 0) return;
    (void)hipMemsetAsync((char*)d_ws + WS_CTL, 0, CTL_ZERO_BYTES, stream);
    Args a{};
    for (int i = 0; i < 13; ++i) a.in[i] = (const float*)d_in[i];
    a.out = (float*)d_out; a.ws = (unsigned char*)d_ws;
#if MK_N_LAUNCHES == 1
    a.ph_lo = 0; a.ph_hi = 6;
    void* kargs[] = {&a};
    hipError_t e = hipLaunchCooperativeKernel((const void*)mk_fwd, dim3(grid), dim3(NWAVES * 64), kargs, LDS_BYTES, stream);
    if (e != hipSuccess) fprintf(stderr, "cooperative launch failed: %s (grid %d)\n", hipGetErrorString(e), grid);
#else
    for (int li = 0; li < 6; ++li) { a.ph_lo = li; a.ph_hi = li + 1; hipLaunchKernelGGL(mk_fwd, dim3(grid), dim3(NWAVES * 64), LDS_BYTES, stream, a); }
#endif
}
```

```cpp
#include <hip/hip_runtime.h>
#include <hip/hip_cooperative_groups.h>
#include <cstdio>
#include <cstdint>
namespace cg = cooperative_groups;

#ifndef MK_N_LAUNCHES
#define MK_N_LAUNCHES 1
#endif

namespace pg8 {
#define PG8_LAS __attribute__((address_space(3)))
typedef unsigned short bf16_t;
typedef short bf16x8 __attribute__((ext_vector_type(8)));
typedef float f32x4 __attribute__((ext_vector_type(4)));
typedef unsigned u32x4 __attribute__((ext_vector_type(4)));
constexpr int BM = 256, BK = 64, HALF = 128, HTB = HALF * BK * 2  , STAGE_BYTES = 8 * HTB, NXCD = 8, WGM = 8;

__host__ __device__ __forceinline__ int lds_byte(int r, int c) { const int st = (r >> 4) * 2 + (c >> 5), rr = r & 15, cc = c & 31, ob = rr * 64 + cc * 2; return st * 1024 + (ob ^ (((ob >> 9) & 1) << 5)); }
__host__ __device__ __forceinline__ void stage_rc(int b, int& R, int& C) { const int st = b / 1024, sb = b % 1024, swz = sb ^ (((sb >> 9) & 1) << 5); R = (st >> 1) * 16 + swz / 64; C = (st & 1) * 32 + (swz % 64) / 2; }
__host__ __device__ __forceinline__ int perm32(int rho) { const int n = rho >> 4, i = rho & 15; return 8 * (i >> 2) + 4 * n + (i & 3); }

struct Unit { int pm, pn; };
struct Gemm { const bf16_t* A; const bf16_t* Bt; int lda, ldb, K, aShift; };

struct StaticOrder {
    int nM, nN, nwg, G, c;
    __host__ __device__ __forceinline__ void init(int nM_, int nN_, int G_, int c_) { nM = nM_; nN = nN_; nwg = nM * nN; G = G_; c = c_; }
    __host__ __device__ __forceinline__ bool next(int i, Unit& u) const {
        const long L = (long)i * G + c; if (L >= nwg) return false;
        int wgid = (int)L; { const int q = nwg / NXCD, r = nwg % NXCD, xcd = wgid % NXCD, off = wgid / NXCD; wgid = (xcd < r ? xcd * (q + 1) : r * (q + 1) + (xcd - r) * q) + off; }
        const int nig = WGM * nN, gid = wgid / nig, fm = gid * WGM, gsz = (nM - fm) < WGM ? (nM - fm) : WGM;
        u.pm = fm + ((wgid % nig) % gsz); u.pn = (wgid % nig) / gsz; return true;
    }
};

__device__ __forceinline__ unsigned cvt_pk_bf16(float lo, float hi) { unsigned r; asm volatile("v_cvt_pk_bf16_f32 %0, %1, %2" : "=v"(r) : "v"(lo), "v"(hi)); return r; }

template <class Epi, class Sched, bool ALIGN_EPI>
__device__ __forceinline__ void gemm_phase(PG8_LAS unsigned char* lds, const Gemm g, const Sched& S, const Epi& E) {
    int tid_ = threadIdx.x; asm volatile("" : "+v"(tid_));
    const int tid = tid_, wid = __builtin_amdgcn_readfirstlane(tid >> 6), lane = tid & 63, wr = wid >> 2, wc = wid & 3, fr = lane & 15, fq = lane >> 4;
    const int K = g.K, nt = K / BK;
    unsigned voffA[2], voffB[2];
#pragma unroll
    for (int i = 0; i < 2; ++i) { int R, C; stage_rc(tid * 16 + i * 8192, R, C); const int Rb = Epi::PERM ? ((R & ~31) + perm32(R & 31)) : R;
        voffA[i] = (unsigned)(R * g.lda + C) * 2u; voffB[i] = (unsigned)(Rb * g.ldb + C) * 2u; }
    const size_t kstep = (size_t)(BK * 2);
    const size_t hstepA = (size_t)HALF * g.lda * 2, hstepB = (size_t)HALF * g.ldb * 2;
    const size_t tstepA = 2 * hstepA, tstepB = 2 * hstepB;
    const unsigned ldsw = (unsigned)wid * 1024u;
    const int aoff = lds_byte(wr * 64 + fr, fq * 8), boff = lds_byte(wc * 32 + fr, fq * 8);
#define PG8_SA(b, h) (((b) * 2 + (h)) * HTB)
#define PG8_SB(b, h) ((4 + (b) * 2 + (h)) * HTB)
#define PG8_STAGE(bufoff, gbase, voff) do { _Pragma("unroll") for (int _i = 0; _i < 2; ++_i) \
        __builtin_amdgcn_global_load_lds((const unsigned*)((const char*)(gbase) + (voff)[_i]), (PG8_LAS unsigned*)(lds + (bufoff) + ldsw + _i * 8192), 16, 0, 0); } while (0)
#define PG8_LDA(dst, b, h) do { _Pragma("unroll") for (int m = 0; m < 4; ++m) _Pragma("unroll") for (int k = 0; k < 2; ++k) dst[m][k] = *(const PG8_LAS bf16x8*)(lds + PG8_SA(b, h) + aoff + m * 2048 + k * 1024); } while (0)
#define PG8_LDB(dst, b, h) do { _Pragma("unroll") for (int n = 0; n < 2; ++n) _Pragma("unroll") for (int k = 0; k < 2; ++k) dst[n][k] = *(const PG8_LAS bf16x8*)(lds + PG8_SB(b, h) + boff + n * 2048 + k * 1024); } while (0)
#define PG8_MMA(ai, bj, At, Bt) do { __builtin_amdgcn_s_setprio(1); _Pragma("unroll") for (int m = 0; m < 4; ++m) _Pragma("unroll") for (int n = 0; n < 2; ++n) _Pragma("unroll") for (int k = 0; k < 2; ++k) \
        acc[ai][bj][m][n] = __builtin_amdgcn_mfma_f32_16x16x32_bf16(Bt[n][k], At[m][k], acc[ai][bj][m][n], 0, 0, 0); __builtin_amdgcn_s_setprio(0); } while (0)
#define PG8_WAIT_V(n) asm volatile("s_waitcnt vmcnt(" #n ")" ::: "memory")
#define PG8_WAIT_L(n) asm volatile("s_waitcnt lgkmcnt(" #n ")" ::: "memory")
#define PG8_BAR __builtin_amdgcn_s_barrier()
#define PG8_SCHED __builtin_amdgcn_sched_barrier(0)
    Unit cur, nxt; int ui = 0;
    if (!S.next(0, cur)) return;
    f32x4 acc[2][2][4][2];
#pragma unroll
    for (int a = 0; a < 2; ++a)
#pragma unroll
        for (int b = 0; b < 2; ++b)
#pragma unroll
            for (int m = 0; m < 4; ++m)
#pragma unroll
                for (int n = 0; n < 2; ++n) acc[a][b][m][n] = (f32x4){0.f, 0.f, 0.f, 0.f};
    bf16x8 At[4][2], B0[2][2], B1[2][2];
    const char* cA = (const char*)g.A + (size_t)cur.pm * tstepA + (size_t)cur.pn * g.aShift; const char* cB = (const char*)g.Bt + (size_t)cur.pn * tstepB;
    PG8_STAGE(PG8_SB(0, 0), cB, voffB); PG8_STAGE(PG8_SB(0, 1), cB + hstepB, voffB); PG8_STAGE(PG8_SA(0, 0), cA, voffA); PG8_STAGE(PG8_SA(0, 1), cA + hstepA, voffA);
    if (wr == 1) PG8_BAR;
    PG8_WAIT_V(2); PG8_BAR;
    PG8_STAGE(PG8_SB(1, 0), cB + kstep, voffB); PG8_STAGE(PG8_SA(1, 0), cA + kstep, voffA); PG8_STAGE(PG8_SB(1, 1), cB + hstepB + kstep, voffB);
    PG8_WAIT_V(6); PG8_BAR;
    for (;;) {
        const bool has_next = S.next(ui + 1, nxt);
        const char* nA = has_next ? (const char*)g.A + (size_t)nxt.pm * tstepA + (size_t)nxt.pn * g.aShift : cA; const char* nB = has_next ? (const char*)g.Bt + (size_t)nxt.pn * tstepB : cB;
        for (int t = 0; t < nt; t += 2) {
            const bool last = (t == nt - 2);
            const char* a1 = cA + (size_t)(t + 1) * kstep;
            const char* a2 = last ? nA : cA + (size_t)(t + 2) * kstep; const char* b2 = last ? nB : cB + (size_t)(t + 2) * kstep;
            const char* a3 = a2 + kstep; const char* b3 = b2 + kstep;
            PG8_LDB(B0, 0, 0); PG8_LDB(B1, 0, 1); PG8_SCHED; PG8_LDA(At, 0, 0); PG8_STAGE(PG8_SA(1, 1), a1 + hstepA, voffA);
            PG8_WAIT_V(8); PG8_WAIT_L(0); PG8_BAR; PG8_MMA(0, 0, At, B0); PG8_MMA(0, 1, At, B1); PG8_BAR; PG8_SCHED;
            PG8_LDA(At, 0, 1); PG8_STAGE(PG8_SB(0, 0), b2, voffB); PG8_STAGE(PG8_SB(0, 1), b2 + hstepB, voffB); PG8_STAGE(PG8_SA(0, 0), a2, voffA);
            PG8_WAIT_V(8); PG8_WAIT_L(0); PG8_BAR; PG8_MMA(1, 0, At, B0); PG8_MMA(1, 1, At, B1); PG8_BAR; PG8_SCHED;
            PG8_LDB(B0, 1, 0); PG8_LDB(B1, 1, 1); PG8_SCHED; PG8_LDA(At, 1, 0); PG8_STAGE(PG8_SA(0, 1), a2 + hstepA, voffA);
            PG8_WAIT_V(8); PG8_WAIT_L(0); PG8_BAR; PG8_MMA(0, 0, At, B0); PG8_MMA(0, 1, At, B1); PG8_BAR; PG8_SCHED;
            PG8_LDA(At, 1, 1); PG8_STAGE(PG8_SB(1, 0), b3, voffB); PG8_STAGE(PG8_SB(1, 1), b3 + hstepB, voffB); PG8_STAGE(PG8_SA(1, 0), a3, voffA);
            PG8_WAIT_V(8); PG8_WAIT_L(0); PG8_BAR; PG8_MMA(1, 0, At, B0); PG8_MMA(1, 1, At, B1); PG8_BAR; PG8_SCHED;
        }
        if constexpr (ALIGN_EPI) { if (wr == 0) PG8_BAR; }
        E(acc, cur, wr, wc, fr, fq);
        if (!has_next) break;
#pragma unroll
        for (int a = 0; a < 2; ++a)
#pragma unroll
            for (int b = 0; b < 2; ++b)
#pragma unroll
                for (int m = 0; m < 4; ++m)
#pragma unroll
                    for (int n = 0; n < 2; ++n) acc[a][b][m][n] = (f32x4){0.f, 0.f, 0.f, 0.f};
        cur = nxt; cA = nA; cB = nB; ++ui;
        if constexpr (ALIGN_EPI) { if (wr == 1) PG8_BAR; }
    }
    PG8_WAIT_V(0);
    if constexpr (!ALIGN_EPI) { if (wr == 0) PG8_BAR; }
    PG8_BAR;
#undef PG8_SA
#undef PG8_SB
#undef PG8_STAGE
#undef PG8_LDA
#undef PG8_LDB
#undef PG8_MMA
#undef PG8_WAIT_V
#undef PG8_WAIT_L
#undef PG8_BAR
#undef PG8_SCHED
}
}

constexpr int NWAVES = 8;
constexpr int DM = 1024, NBP = 16, TP = 2048, NBS = 16, TS = 64;
constexpr int MP = NBP * TP, MS = NBS * TS, M = MP + MS;
constexpr int LDZ = 5184;
constexpr int ZU = 0, ZQ = 1024, ZK = 1536, ZV = 2048, ZGP = 3072, ZGG = 4096, ZLR = 5120;
constexpr int NIN = 5136, NINP = 5376;
constexpr int NM = M / 256;
constexpr float EPS = 1e-6f;
constexpr size_t O_Y = 0, O_NPP = (size_t)M * DM, O_NGP = O_NPP + 16 * 15 * 1024, O_NPS = O_NGP + 16 * 4 * 128 * 256, O_NGS = O_NPS + 16 * 15 * 1024, O_END = O_NGS + 16 * 4 * 128 * 256;

constexpr size_t MiB = 1u << 20;
constexpr size_t WS_CTL = 0, CTL_ZERO_BYTES = 48 * 1024;
constexpr size_t WS_WIN = 2 * MiB;
constexpr size_t WS_WOUT = 13 * MiB;
constexpr size_t WS_WP = 17 * MiB;
constexpr size_t WS_PART = 18 * MiB;
constexpr size_t WS_XN = 24 * MiB;
constexpr size_t WS_Z = 96 * MiB;
constexpr size_t WS_ZEND = WS_Z + (size_t)M * LDZ * 2;
constexpr size_t WS_SLOC = 432 * MiB;
constexpr size_t WS_BSEG = 457 * MiB;
constexpr size_t WS_SLAB = 460 * MiB;
constexpr size_t WS_END = 476 * MiB;
static_assert(WS_ZEND <= WS_SLOC && WS_SLOC + 192ull * 131072 <= WS_BSEG, "ws map 2");
static_assert(WS_WIN + (size_t)NINP * 1024 * 2 <= WS_WOUT && WS_PART + (size_t)M * 64 <= WS_XN && WS_XN + (size_t)M * 2048 <= WS_Z, "ws map");
constexpr int CW_BAR = 0;

constexpr int RING_BYTES = 131072;
constexpr int PU_STG = 65536, PU_STG_BYTES = 144 * 512;
constexpr int CTL_BASE = PU_STG + PU_STG_BYTES;
constexpr int LDSCTL_OFF = CTL_BASE, MISC_OFF = LDSCTL_OFF + 320;
constexpr int LDS_BYTES = CTL_BASE + 16384;

#define GAS __attribute__((address_space(1)))
#define LAS __attribute__((address_space(3)))
typedef unsigned short bf16;
typedef unsigned v4u __attribute__((ext_vector_type(4)));
typedef unsigned v2u __attribute__((ext_vector_type(2)));
typedef float f32x2v __attribute__((ext_vector_type(2)));
typedef float f32x4 __attribute__((ext_vector_type(4)));
typedef float f32x16 __attribute__((ext_vector_type(16)));
typedef short bf16x8 __attribute__((ext_vector_type(8)));
typedef GAS unsigned gu32;
#define RLX_AGENT __ATOMIC_RELAXED, __HIP_MEMORY_SCOPE_AGENT
#define LDS_WAIT() asm volatile("s_waitcnt lgkmcnt(0)" ::: "memory")
__device__ __forceinline__ unsigned f2bf(float f) { unsigned u = __builtin_bit_cast(unsigned, f); return (u + 0x7fffu + ((u >> 16) & 1u)) >> 16; }
__device__ __forceinline__ unsigned pk2(float lo, float hi) { return f2bf(lo) | (f2bf(hi) << 16); }
__device__ __forceinline__ float bf2f(unsigned u16) { return __builtin_bit_cast(float, u16 << 16); }
__device__ __forceinline__ float bflo(unsigned w) { return __builtin_bit_cast(float, w << 16); }
__device__ __forceinline__ float bfhi(unsigned w) { return __builtin_bit_cast(float, w & 0xffff0000u); }
__device__ __forceinline__ float silu_f(float x) { return x * __builtin_amdgcn_rcpf(1.0f + __expf(-x)); }

#define XB_TMO      128
#define XB_XCNT(j)  (256  + 64 * (j))
#define XB_XSUB(j)  (1280 + 64 * (j))
#define XB_XGEN(j)  (2304 + 64 * (j))
#define XB_TOP      3328
#define XB_TOPGEN   3392
#define XCD_BAR_WORDS 3456
#define XB_SPIN_CAP (1u << 18)
__device__ __forceinline__ unsigned xb_ld(unsigned* p)              { return __hip_atomic_load(p, __ATOMIC_RELAXED, __HIP_MEMORY_SCOPE_AGENT); }
__device__ __forceinline__ unsigned xb_add(unsigned* p, unsigned v) { return __hip_atomic_fetch_add(p, v, __ATOMIC_RELAXED, __HIP_MEMORY_SCOPE_AGENT); }
__device__ __forceinline__ unsigned xb_xcc_id() { return (unsigned)__builtin_amdgcn_s_getreg((3 << 11) | 20) & 0xFu; }
#define XB_SPIN(cond, bar) do { unsigned _sp = 0; while (cond) { __builtin_amdgcn_s_sleep(1); \
    if ((++_sp & 255u) == 0u) { if (xb_ld(&(bar)[XB_TMO])) break; if (_sp > XB_SPIN_CAP) { atomicAdd(&(bar)[XB_TMO], 1u); break; } } } } while (0)
struct XcdBarrier { unsigned* bar; unsigned x; volatile LAS unsigned* st; };
__device__ __forceinline__ XcdBarrier xcd_barrier_post(unsigned* bar, volatile LAS unsigned* st) {
    XcdBarrier b; b.bar = bar; b.x = xb_xcc_id(); b.st = st;
    if (threadIdx.x == 0) (void)xb_add(&bar[XB_XCNT(b.x)], 1u);
    return b;
}
__device__ __forceinline__ void xcd_barrier_complete(unsigned* bar, unsigned x, unsigned& nloc, unsigned& nx) {
    const unsigned G = gridDim.x * gridDim.y * gridDim.z;
    unsigned sum, cnt, mine, sp = 0u;
    for (;;) {
        sum = 0u; cnt = 0u; mine = 0u;
#pragma unroll
        for (unsigned j = 0; j < 16; ++j) { const unsigned c = xb_ld(&bar[XB_XCNT(j)]); sum += c; cnt += (c > 0u) ? 1u : 0u; mine = (j == x) ? c : mine; }
        if (sum == G) break;
        __builtin_amdgcn_s_sleep(1);
        if ((++sp & 255u) == 0u) { if (xb_ld(&bar[XB_TMO])) break; if (sp > XB_SPIN_CAP) { atomicAdd(&bar[XB_TMO], 1u); break; } }
    }
    nloc = mine > 0u ? mine : 1u; nx = cnt > 0u ? cnt : 1u;
}
__device__ __forceinline__ void xcd_barrier(const XcdBarrier& b) {
    asm volatile("s_waitcnt vmcnt(0)" ::: "memory");
    __syncthreads();
    if (threadIdx.x == 0) {
        unsigned* bar = b.bar;
        __builtin_amdgcn_s_waitcnt(0);
        unsigned nloc = b.st[0], nx = b.st[1];
        if (nloc == 0u) { xcd_barrier_complete(bar, b.x, nloc, nx); b.st[0] = nloc; b.st[1] = nx; }
        const unsigned old = xb_add(&bar[XB_XSUB(b.x)], 1u);
        const unsigned gen = old / nloc;
        if (old + 1u == (gen + 1u) * nloc) {
            __builtin_amdgcn_fence(__ATOMIC_RELEASE, "agent");
            asm volatile("s_waitcnt vmcnt(0)" ::: "memory");
            const unsigned og = xb_add(&bar[XB_TOP], 1u);
            const unsigned tg = og / nx;
            if (og + 1u == (tg + 1u) * nx) xb_add(&bar[XB_TOPGEN], 1u);
            else XB_SPIN(xb_ld(&bar[XB_TOPGEN]) == tg, bar);
            __builtin_amdgcn_fence(__ATOMIC_ACQUIRE, "agent");
            xb_add(&bar[XB_XGEN(b.x)], 1u);
            asm volatile("s_waitcnt vmcnt(0)" ::: "memory");
        } else {
            XB_SPIN(xb_ld(&bar[XB_XGEN(b.x)]) == gen, bar);
            __builtin_amdgcn_fence(__ATOMIC_ACQUIRE, "agent");
            asm volatile("s_waitcnt vmcnt(0)" ::: "memory");
        }
    }
    __syncthreads();
}

struct EpiZ {
    static constexpr bool PERM = true;
    bf16* Z; const float* pscale;
    __device__ __forceinline__ void operator()(const f32x4 (&acc)[2][2][4][2], const pg8::Unit& u, int wr, int wc, int fr, int fq) const {
        const int row0 = u.pm * 256 + wr * 64 + fr, col0 = u.pn * 256 + wc * 32 + 8 * fq;
        const int pn = u.pn; const bool dosilu = (pn >= 12 && pn < 20), lr = (pn == 20);
        const float sc = (pn == 4 || pn == 5) ? 0.08838834764831845f : 1.0f;
#pragma unroll
        for (int ai = 0; ai < 2; ++ai)
#pragma unroll
            for (int m = 0; m < 4; ++m) { bf16* rowp = Z + (size_t)(row0 + ai * 128 + m * 16) * LDZ + col0;
#pragma unroll
                for (int bj = 0; bj < 2; ++bj) { f32x4 v0 = acc[ai][bj][m][0], v1 = acc[ai][bj][m][1];
                    if (dosilu) { v0 = (f32x4){silu_f(v0[0]), silu_f(v0[1]), silu_f(v0[2]), silu_f(v0[3])}; v1 = (f32x4){silu_f(v1[0]), silu_f(v1[1]), silu_f(v1[2]), silu_f(v1[3])}; }
                    v0 = v0 * sc; v1 = v1 * sc;
                    if (pn >= 12 && pn < 16) { v0 = v0 * *(const f32x4*)(pscale + col0 - ZGP + bj * 128); v1 = v1 * *(const f32x4*)(pscale + col0 - ZGP + bj * 128 + 4); }
                    v4u w; w.x = pg8::cvt_pk_bf16(v0[0], v0[1]); w.y = pg8::cvt_pk_bf16(v0[2], v0[3]); w.z = pg8::cvt_pk_bf16(v1[0], v1[1]); w.w = pg8::cvt_pk_bf16(v1[2], v1[3]);
                    if (!lr || (bj == 0 && wc == 0 && fq < 2)) *(v4u*)(rowp + bj * 128) = w; } }
    }
};
struct EpiPool {
    static constexpr bool PERM = true;
    bf16* Z;
    __device__ __forceinline__ void operator()(const f32x4 (&acc)[2][2][4][2], const pg8::Unit& u, int wr, int wc, int fr, int fq) const {
        const int row0 = u.pm * 256 + wr * 64 + fr, col0 = u.pn * 256 + wc * 32 + 8 * fq;
        bf16* base = Z + (size_t)row0 * LDZ + ZGP + col0;
#pragma unroll
        for (int ai = 0; ai < 2; ++ai)
#pragma unroll
          for (int mp = 0; mp < 2; ++mp) {
            v4u gs[2][2];
#pragma unroll
            for (int mm = 0; mm < 2; ++mm)
#pragma unroll
                for (int bj = 0; bj < 2; ++bj) gs[mm][bj] = *(const v4u*)(base + (size_t)(ai * 128 + (2 * mp + mm) * 16) * LDZ + bj * 128);
            __builtin_amdgcn_sched_barrier(0);
#pragma unroll
            for (int mm = 0; mm < 2; ++mm)
#pragma unroll
                for (int bj = 0; bj < 2; ++bj) { const int m = 2 * mp + mm; const v4u gsg = gs[mm][bj];
                    const f32x4 v0 = acc[ai][bj][m][0] * (f32x4){bflo(gsg.x), bfhi(gsg.x), bflo(gsg.y), bfhi(gsg.y)}, v1 = acc[ai][bj][m][1] * (f32x4){bflo(gsg.z), bfhi(gsg.z), bflo(gsg.w), bfhi(gsg.w)};
                    v4u w; w.x = pg8::cvt_pk_bf16(v0[0], v0[1]); w.y = pg8::cvt_pk_bf16(v0[2], v0[3]); w.z = pg8::cvt_pk_bf16(v1[0], v1[1]); w.w = pg8::cvt_pk_bf16(v1[2], v1[3]);
                    *(v4u*)(base + (size_t)(ai * 128 + m * 16) * LDZ + bj * 128) = w; }
            __builtin_amdgcn_sched_barrier(0);
          }
    }
};
struct OneUnit { int pm, pn; __device__ __forceinline__ bool next(int i, pg8::Unit& u) const { if (i) return false; u.pm = pm; u.pn = pn; return true; } };
struct EpiSlab {
    static constexpr bool PERM = false;
    float* slab;
    __device__ __forceinline__ void operator()(const f32x4 (&acc)[2][2][4][2], const pg8::Unit&, int wr, int wc, int fr, int fq) const {
#pragma unroll
        for (int ai = 0; ai < 2; ++ai)
#pragma unroll
            for (int m = 0; m < 4; ++m) { float* rowp = slab + (size_t)(ai * 128 + wr * 64 + m * 16 + fr) * 256 + wc * 32 + 4 * fq;
#pragma unroll
                for (int bj = 0; bj < 2; ++bj)
#pragma unroll
                    for (int n = 0; n < 2; ++n) *(f32x4*)(rowp + bj * 128 + n * 16) = acc[ai][bj][m][n]; }
    }
};
struct PanelOrder {
    int c, npanel;
    __device__ __forceinline__ bool next(int i, pg8::Unit& u) const { const int x = c & 7, y = c >> 3; const int p = i * 64 + x * 8 + (y >> 2); if (p >= npanel) return false; u.pm = p; u.pn = y & 3; return true; }
};
constexpr int CW_CNT = 3584;
constexpr int XL_OFF = CTL_BASE + 1024;
struct EpiRmsRes {
    static constexpr bool PERM = false;
    const float* xp; const float* xs; const float* gpost; float* out; float* xbuf; unsigned* cnt; LAS unsigned char* lds;
    __device__ __forceinline__ void operator()(const f32x4 (&acc)[2][2][4][2], const pg8::Unit& u, int wr, int wc, int fr, int fq) const {
        LAS float* P = (LAS float*)(lds + XL_OFF); LAS float* S = (LAS float*)(lds + XL_OFF + 4096); LAS unsigned* flag = (LAS unsigned*)(lds + XL_OFF + 5120);
        const int tid = threadIdx.x, wid = __builtin_amdgcn_readfirstlane(tid >> 6), lane = tid & 63;
        const int col0 = u.pn * 256 + wc * 32 + 4 * fq;
        const int prow0 = u.pm * 256;
        const float* xbase = prow0 < MP ? xp + (size_t)prow0 * DM : xs + (size_t)(prow0 - MP) * DM;
        f32x4 xa[2][2], xb[2][2];
#define RMS_LOADX(buf, grp) do { const size_t off_ = (size_t)(((grp) >> 2) * 128 + wr * 64 + ((grp) & 3) * 16 + fr) * DM + col0; \
            _Pragma("unroll") for (int bj = 0; bj < 2; ++bj) _Pragma("unroll") for (int n = 0; n < 2; ++n) buf[bj][n] = *(const f32x4*)(xbase + off_ + bj * 128 + n * 16); } while (0)
        RMS_LOADX(xa, 0); RMS_LOADX(xb, 1);
#pragma unroll
        for (int ai = 0; ai < 2; ++ai)
#pragma unroll
            for (int m = 0; m < 4; ++m) { float s = 0.f;
#pragma unroll
                for (int bj = 0; bj < 2; ++bj)
#pragma unroll
                    for (int n = 0; n < 2; ++n) { const f32x4 x = acc[ai][bj][m][n]; s += (x[0] * x[0] + x[1] * x[1]) + (x[2] * x[2] + x[3] * x[3]); }
                s += __shfl_xor(s, 16); s += __shfl_xor(s, 32);
                if (fq == 0) P[(ai * 128 + wr * 64 + m * 16 + fr) * 4 + wc] = s; }
        asm volatile("s_waitcnt lgkmcnt(0)" ::: "memory"); __builtin_amdgcn_s_barrier(); asm volatile("" ::: "memory");
        if (wid < 4) { const f32x4 p4 = *(const LAS f32x4*)(P + tid * 4); const float rs = (p4.x + p4.y) + (p4.z + p4.w);
            __hip_atomic_store((unsigned*)xbuf + (size_t)(prow0 + tid) * 4 + u.pn, __float_as_uint(rs), __ATOMIC_RELAXED, __HIP_MEMORY_SCOPE_AGENT);
            asm volatile("s_waitcnt vmcnt(0)" ::: "memory");
            if (lane == 0) __hip_atomic_fetch_add(cnt + 64 * u.pm, 1u, __ATOMIC_RELAXED, __HIP_MEMORY_SCOPE_AGENT); }
        if (wid == 0) { unsigned spins = 0;
            while ((unsigned)__builtin_amdgcn_readfirstlane(__hip_atomic_load(cnt + 64 * u.pm, __ATOMIC_RELAXED, __HIP_MEMORY_SCOPE_AGENT)) < 16u) { __builtin_amdgcn_s_sleep(2); if (++spins > (1u << 22)) break; }
            __builtin_amdgcn_fence(__ATOMIC_ACQUIRE, "agent");
            if (lane == 0) flag[0] = spins; }
        asm volatile("s_waitcnt vmcnt(0) lgkmcnt(0)" ::: "memory"); __builtin_amdgcn_s_barrier(); asm volatile("" ::: "memory");
        if (wid < 4) { const unsigned* slot = (const unsigned*)xbuf + (size_t)(prow0 + tid) * 4; float tot = 0.f;
#pragma unroll
            for (int t = 0; t < 4; ++t) tot += __uint_as_float(__hip_atomic_load(slot + t, __ATOMIC_RELAXED, __HIP_MEMORY_SCOPE_AGENT));
            S[tid] = __builtin_amdgcn_rsqf(tot * (1.0f / DM) + EPS); }
        asm volatile("s_waitcnt vmcnt(0) lgkmcnt(0)" ::: "memory"); __builtin_amdgcn_s_barrier(); asm volatile("" ::: "memory");
        f32x4 gp[2][2];
#pragma unroll
        for (int bj = 0; bj < 2; ++bj)
#pragma unroll
            for (int n = 0; n < 2; ++n) gp[bj][n] = *(const f32x4*)(gpost + col0 + bj * 128 + n * 16);
        float* obase = out + (size_t)prow0 * DM;
#define RMS_STORE(buf, grp) do { const int ai_ = (grp) >> 2, m_ = (grp) & 3; const int r_ = ai_ * 128 + wr * 64 + m_ * 16 + fr; const float rinv_ = S[r_]; const size_t off_ = (size_t)r_ * DM + col0; \
            _Pragma("unroll") for (int bj = 0; bj < 2; ++bj) _Pragma("unroll") for (int n = 0; n < 2; ++n) *(f32x4*)(obase + off_ + bj * 128 + n * 16) = buf[bj][n] + acc[ai_][bj][m_][n] * rinv_ * gp[bj][n]; } while (0)
#define SB __builtin_amdgcn_sched_barrier(0)
        RMS_STORE(xa, 0); SB; RMS_LOADX(xa, 2); SB; RMS_STORE(xb, 1); SB; RMS_LOADX(xb, 3); SB;
        RMS_STORE(xa, 2); SB; RMS_LOADX(xa, 4); SB; RMS_STORE(xb, 3); SB; RMS_LOADX(xb, 5); SB;
        RMS_STORE(xa, 4); SB; RMS_LOADX(xa, 6); SB; RMS_STORE(xb, 5); SB; RMS_LOADX(xb, 7); SB;
        RMS_STORE(xa, 6); SB; RMS_STORE(xb, 7);
#undef SB
#undef RMS_LOADX
#undef RMS_STORE
    }
};

struct Args { const float* in[13]; float* out; unsigned char* ws; int ph_lo, ph_hi; };
struct Frame {
    LAS unsigned char* lds;
    int tid, lane, wave, G;
};
#define A_XP(a) ((a).in[0])
#define A_XS(a) ((a).in[1])
#define A_SPOOL(a) ((a).in[2])
#define A_SGLA(a) ((a).in[3])
#define A_GPRE(a) ((a).in[4])
#define A_WIN(a) ((a).in[5])
#define A_WGU(a) ((a).in[6])
#define A_BGU(a) ((a).in[7])
#define A_WPOOL(a) ((a).in[8])
#define A_PSCALE(a) ((a).in[9])
#define A_GGO(a) ((a).in[10])
#define A_WOUT(a) ((a).in[11])
#define A_GPOST(a) ((a).in[12])
#define A_WINT(a) ((bf16*)((a).ws + WS_WIN))
#define A_WOUTT(a) ((bf16*)((a).ws + WS_WOUT))
#define A_WPT(a) ((bf16*)((a).ws + WS_WP))
#define A_XN(a) ((bf16*)((a).ws + WS_XN))
#define A_Z(a) ((bf16*)((a).ws + WS_Z))
#define A_PART(a) ((float*)((a).ws + WS_PART))
__device__ __forceinline__ float wave_sum(float v) {
#pragma unroll
    for (int o = 1; o < 64; o <<= 1) v += __shfl_xor(v, o);
    return v;
}
__device__ __forceinline__ const float* xrow(const Args& A, int m) { return m < MP ? A_XP(A) + (size_t)m * DM : A_XS(A) + (size_t)(m - MP) * DM; }

__device__ __forceinline__ void p0_transpose_item(const float* W, int K, int N, bf16* WT, int dstrow0, int nsrc0, int nvalid, int k0, LAS float* scr, int lane) {
    { f32x4 v[8]; const int n4 = (lane & 7) * 4;
#pragma unroll
      for (int i = 0; i < 8; ++i) { const int kk = 8 * i + (lane >> 3); v[i] = (n4 < nvalid) ? __builtin_nontemporal_load((const f32x4*)(W + (size_t)(k0 + kk) * N + nsrc0 + n4)) : (f32x4){0.f, 0.f, 0.f, 0.f}; }
#pragma unroll
      for (int i = 0; i < 8; ++i) { const int kk = 8 * i + (lane >> 3); LAS float* d = scr + kk * 33 + n4; d[0] = v[i].x; d[1] = v[i].y; d[2] = v[i].z; d[3] = v[i].w; } }
    LDS_WAIT(); asm volatile("" ::: "memory");
    const int c = lane & 7;
#pragma unroll
    for (int j = 0; j < 4; ++j) { const int n = (lane >> 3) + 8 * j; const LAS float* s = scr + (8 * c) * 33 + n;
        v4u o; o.x = pk2(s[0 * 33], s[1 * 33]); o.y = pk2(s[2 * 33], s[3 * 33]); o.z = pk2(s[4 * 33], s[5 * 33]); o.w = pk2(s[6 * 33], s[7 * 33]);
        *(GAS v4u*)(WT + (size_t)(dstrow0 + n) * K + k0 + 8 * c) = o; }
    LDS_WAIT(); asm volatile("" ::: "memory");
}
__device__ __forceinline__ void p0_prologue(Frame& F, const Args& A) {
    LAS float* scr = (LAS float*)(F.lds + F.wave * 16384);
    const int gw = blockIdx.x * NWAVES + F.wave, NGW = F.G * NWAVES;
    constexpr int I_IN = (1024 / 64) * (NINP / 32), I_OUT = (2048 / 64) * (1024 / 32), I_P = 4 * (256 / 64) * (256 / 32);
    f32x4 gp[4];
#pragma unroll
    for (int j = 0; j < 4; ++j) gp[j] = *((const f32x4*)A_GPRE(A) + F.lane + 64 * j);
    f32x4 c0[4], c1[4], n0[4], n1[4];
#define XN_LOAD(d0, d1, mm) do { const int m1_ = (mm) + NGW; const GAS f32x4* p0_ = (const GAS f32x4*)xrow(A, (mm) < M ? (mm) : gw) + F.lane; const GAS f32x4* p1_ = (const GAS f32x4*)xrow(A, m1_ < M ? m1_ : gw) + F.lane; \
        _Pragma("unroll") for (int j = 0; j < 4; ++j) d0[j] = __builtin_nontemporal_load(p0_ + 64 * j); _Pragma("unroll") for (int j = 0; j < 4; ++j) d1[j] = __builtin_nontemporal_load(p1_ + 64 * j); } while (0)
    XN_LOAD(c0, c1, gw);
    for (int it = gw; it < I_IN + I_OUT + I_P; it += NGW) {
        int r = it;
        if (r < I_IN) { const int nblk = NINP / 32, kb = r / nblk, nb = r % nblk, n0 = 32 * nb;
            int src = n0, nvalid = 32;
            if (n0 >= 1024 && n0 < 3072) src = n0 + 1024; else if (n0 >= 3072 && n0 < 4096) src = n0 - 2048;
            if (n0 == 5120) nvalid = 16; else if (n0 > 5120) { nvalid = 0; src = 0; }
            p0_transpose_item(A_WIN(A), 1024, NIN, A_WINT(A), n0, src, nvalid, 64 * kb, scr, F.lane); continue; }
        r -= I_IN;
        if (r < I_OUT) { const int nblk = 1024 / 32, kb = r / nblk, nb = r % nblk; p0_transpose_item(A_WOUT(A), 2048, 1024, A_WOUTT(A), 32 * nb, 32 * nb, 32, 64 * kb, scr, F.lane); continue; }
        r -= I_OUT;
        { const int gq = r / 32, rr = r % 32, kb = rr / 8, nb = rr % 8; p0_transpose_item(A_WPOOL(A) + (size_t)gq * 65536, 256, 256, A_WPT(A), gq * 256 + 32 * nb, 32 * nb, 32, 64 * kb, scr, F.lane); }
    }
    for (int m = gw; m < M; m += 2 * NGW) {
        const int m1 = m + NGW; const bool two = m1 < M;
        XN_LOAD(n0, n1, m + 2 * NGW);
        float s0 = 0.f, s1 = 0.f;
#pragma unroll
        for (int j = 0; j < 4; ++j) { s0 += (c0[j].x * c0[j].x + c0[j].y * c0[j].y) + (c0[j].z * c0[j].z + c0[j].w * c0[j].w); s1 += (c1[j].x * c1[j].x + c1[j].y * c1[j].y) + (c1[j].z * c1[j].z + c1[j].w * c1[j].w); }
        const float r0 = 1.0f / sqrtf(wave_sum(s0) * (1.f / DM) + EPS), r1 = 1.0f / sqrtf(wave_sum(s1) * (1.f / DM) + EPS);
        GAS unsigned long long* o0 = (GAS unsigned long long*)(A_XN(A) + (size_t)m * DM) + F.lane;
#pragma unroll
        for (int j = 0; j < 4; ++j) o0[64 * j] = (unsigned long long)pk2(c0[j].x * r0 * gp[j].x, c0[j].y * r0 * gp[j].y) | ((unsigned long long)pk2(c0[j].z * r0 * gp[j].z, c0[j].w * r0 * gp[j].w) << 32);
        if (two) { GAS unsigned long long* o1 = (GAS unsigned long long*)(A_XN(A) + (size_t)m1 * DM) + F.lane;
#pragma unroll
            for (int j = 0; j < 4; ++j) o1[64 * j] = (unsigned long long)pk2(c1[j].x * r1 * gp[j].x, c1[j].y * r1 * gp[j].y) | ((unsigned long long)pk2(c1[j].z * r1 * gp[j].z, c1[j].w * r1 * gp[j].w) << 32); }
#pragma unroll
        for (int j = 0; j < 4; ++j) { c0[j] = n0[j]; c1[j] = n1[j]; }
    }
#undef XN_LOAD
}

template <int w, int MODE>
__device__ __forceinline__ void poolgen_half(const LAS unsigned char* srow, const float* hist, LAS unsigned char* dA, LAS unsigned char* dB) {
#pragma unroll
    for (int sb = 0; sb < 2; ++sb) {
        unsigned outlo[8];
#pragma unroll
        for (int ep = 0; ep < 2; ++ep) {
            float a[23][2];
#pragma unroll
            for (int i = 0; i < 23; ++i) {
                if (i < 16 - w || (MODE == 1 && 8 * sb + i < 15)) { a[i][0] = 0.f; a[i][1] = 0.f; }
                else if (MODE == 2 && 8 * sb + i < 15) { const f32x2v hv = *(const f32x2v*)(hist + (8 * sb + i) * 1024 + 2 * ep); a[i][0] = hv.x; a[i][1] = hv.y; }
                else { const unsigned wv = *(const LAS unsigned*)(srow + (8 * sb + i) * 512 + 4 * ep); a[i][0] = bflo(wv); a[i][1] = bfhi(wv); } }
            float cur[8][2];
#pragma unroll
            for (int r = 0; r < 8; ++r) { cur[r][0] = a[15 + r][0]; cur[r][1] = a[15 + r][1]; }
#pragma unroll
            for (int i = 22; i >= 1; --i) { a[i][0] += a[i - 1][0]; a[i][1] += a[i - 1][1]; }
            if (w >= 4) {
#pragma unroll
                for (int i = 22; i >= 3; --i) { a[i][0] += a[i - 2][0]; a[i][1] += a[i - 2][1]; } }
            if (w >= 8) {
#pragma unroll
                for (int i = 22; i >= 7; --i) { a[i][0] += a[i - 4][0]; a[i][1] += a[i - 4][1]; } }
            if (w >= 16) {
#pragma unroll
                for (int i = 22; i >= 15; --i) { a[i][0] += a[i - 8][0]; a[i][1] += a[i - 8][1]; } }
#pragma unroll
            for (int r = 0; r < 8; ++r) { const float rc = 1.0f / (float)((MODE == 1 && 8 * sb + r + 1 < w) ? 8 * sb + r + 1 : w);
                const unsigned o = pg8::cvt_pk_bf16(a[15 + r][0] * rc - cur[r][0], a[15 + r][1] * rc - cur[r][1]);
                if (ep == 0) outlo[r] = o; else *(LAS v2u*)((sb ? dB : dA) + r * 64) = (v2u){outlo[r], o}; }
            __builtin_amdgcn_sched_barrier(0);
        }
    }
}
#define OPQ(x) asm volatile("" : "+v"(x))
__device__ __forceinline__ void pool_unit_of(int V, int& R0, int& g) { if (V < 1024) { g = V >> 8; R0 = ((V & 255) >> 1) * 256 + (V & 1) * 128; } else { const int s_ = V - 1024; g = (s_ >> 1) & 3; R0 = (128 + (s_ >> 3)) * 256 + (s_ & 1) * 128; } }
__device__ __forceinline__ void pool_run(Frame& F, const Args& A, int ubeg, int uend) {
    LAS unsigned char* lds = F.lds;
    const int wid = F.wave;
    if (ubeg >= uend) return;
    int R0, g; pool_unit_of(ubeg, R0, g);
    int gB = -1;
#define PU_DMA(R0x, gx) do { int ln_ = F.lane; OPQ(ln_); const char* zb_ = (const char*)A_Z(A) + ((long)((R0x) - 16 + 18 * wid) * LDZ + ZU + (gx) * 256) * 2; \
        const unsigned vo_ = (unsigned)((ln_ >> 5) * (LDZ * 2) + (ln_ & 31) * 16); \
        _Pragma("unroll") for (int q = 0; q < 9; ++q) __builtin_amdgcn_global_load_lds((const unsigned*)(zb_ + vo_ + q * (4 * LDZ)), (LAS unsigned*)(lds + PU_STG + (wid * 9 + q) * 1024), 16, 0, 0); } while (0)
    PU_DMA(R0, g);
    pg8::bf16x8 Bf[2][8];
    for (int nu = 0;; ++nu) {
        int R0n = R0, gn = g; const int un = ubeg + nu + 1; const bool hasn = un < uend; if (hasn) pool_unit_of(un, R0n, gn);
        asm volatile("s_waitcnt vmcnt(0)" ::: "memory"); __syncthreads();
        int lane = F.lane; OPQ(lane);
        const int fr = lane & 15, fq = lane >> 4;
        bf16* base = A_Z(A) + (size_t)(R0 + fr) * LDZ + ZGP + g * 256 + wid * 32 + 8 * fq;
        v4u gs[8];
#pragma unroll
        for (int m = 0; m < 8; ++m) gs[m] = *(const v4u*)(base + (size_t)(16 * m) * LDZ);
        const bf16* wb = A_WPT(A) + (size_t)(g * 256 + wid * 32 + 8 * (fr >> 2) + (fr & 3)) * 256 + 8 * fq;
        if (g != gB) { gB = g;
#pragma unroll
            for (int n = 0; n < 2; ++n)
#pragma unroll
                for (int kk = 0; kk < 8; ++kk) Bf[n][kk] = *(const pg8::bf16x8*)(wb + (4 * n) * 256 + 32 * kk); }
        __builtin_amdgcn_sched_barrier(0);
        { int ln = F.lane; OPQ(ln);
          const int row0 = R0 + wid * 16; const bool samp = row0 >= MP;
          int b, ts; if (!samp) { b = row0 / TP; ts = row0 % TP; } else { b = (row0 - MP) / TS; ts = (row0 - MP) % TS; }
          const int w = 2 << g, c0 = g * 256 + 4 * ln;
          LAS unsigned char* dA = lds + (ln >> 4) * 16384 + (wid * 2 + ((ln >> 3) & 1)) * 1024 + 8 * (ln & 7);
          LAS unsigned char* dB = lds + (ln >> 4) * 16384 + (wid * 2 + ((ln >> 3) & 1)) * 1024 + 512 + ((8 * (ln & 7)) ^ 32);
          const LAS unsigned char* srow = lds + PU_STG + (16 * wid + 1) * 512 + 8 * ln;
          const float* hist = A_SPOOL(A) + (size_t)b * 15 * 1024 + c0;
          const int mode = ts >= 15 ? 0 : (samp ? 2 : 1);
#define PU_GEN(W) do { if (mode == 0) poolgen_half<W, 0>(srow, hist, dA, dB); else if (mode == 1) poolgen_half<W, 1>(srow, hist, dA, dB); else poolgen_half<W, 2>(srow, hist, dA, dB); } while (0)
          if (w == 2) PU_GEN(2); else if (w == 4) PU_GEN(4); else if (w == 8) PU_GEN(8); else PU_GEN(16);
#undef PU_GEN
        }
        __builtin_amdgcn_sched_barrier(0);
#pragma unroll
        for (int m = 0; m < 8; ++m) asm volatile("" : "+v"(gs[m]));
#pragma unroll
        for (int n = 0; n < 2; ++n)
#pragma unroll
            for (int kk = 0; kk < 8; ++kk) asm volatile("" : "+v"(Bf[n][kk]));
        f32x4 acc[8][2];
#pragma unroll
        for (int m = 0; m < 8; ++m)
#pragma unroll
            for (int n = 0; n < 2; ++n) acc[m][n] = (f32x4){0.f, 0.f, 0.f, 0.f};
        LDS_WAIT(); asm volatile("" ::: "memory");
        __builtin_amdgcn_s_barrier();
        asm volatile("" ::: "memory");
        PU_DMA(R0n, gn);
        __builtin_amdgcn_sched_barrier(0);
        const int aoff = pg8::lds_byte(fr, fq * 8);
#pragma unroll
        for (int t = 0; t < 4; ++t)
#pragma unroll
            for (int mh = 0; mh < 2; ++mh) {
                pg8::bf16x8 At[4][2];
#pragma unroll
                for (int m = 0; m < 4; ++m)
#pragma unroll
                    for (int kk = 0; kk < 2; ++kk) At[m][kk] = *(const LAS pg8::bf16x8*)(lds + t * 16384 + aoff + (4 * mh + m) * 2048 + kk * 1024);
#pragma unroll
                for (int m = 0; m < 4; ++m)
#pragma unroll
                    for (int n = 0; n < 2; ++n)
#pragma unroll
                        for (int kk = 0; kk < 2; ++kk) acc[4 * mh + m][n] = __builtin_amdgcn_mfma_f32_16x16x32_bf16(Bf[n][2 * t + kk], At[m][kk], acc[4 * mh + m][n], 0, 0, 0);
            }
#pragma unroll
        for (int m = 0; m < 8; ++m) { const v4u gsg = gs[m];
            const f32x4 v0 = acc[m][0] * (f32x4){bflo(gsg.x), bfhi(gsg.x), bflo(gsg.y), bfhi(gsg.y)}, v1 = acc[m][1] * (f32x4){bflo(gsg.z), bfhi(gsg.z), bflo(gsg.w), bfhi(gsg.w)};
            v4u o; o.x = pg8::cvt_pk_bf16(v0[0], v0[1]); o.y = pg8::cvt_pk_bf16(v0[2], v0[3]); o.z = pg8::cvt_pk_bf16(v1[0], v1[1]); o.w = pg8::cvt_pk_bf16(v1[2], v1[3]);
            *(v4u*)(base + (size_t)(16 * m) * LDZ) = o; }
        if (!hasn) break;
        R0 = R0n; g = gn;
    }
#undef PU_DMA
    asm volatile("s_waitcnt vmcnt(0)" ::: "memory"); __syncthreads();
}
__device__ __forceinline__ void newpool_copy(Frame& F, const Args& A) {
    const int gw = blockIdx.x * NWAVES + F.wave, NGW = F.G * NWAVES;
    for (int r = gw; r < 32 * 15; r += NGW) { const int s = r / 15, i = r % 15;
        const int src = s < 16 ? s * TP + (TP - 15) + i : MP + (s - 16) * TS + (TS - 15) + i;
        float* dst = A.out + (s < 16 ? O_NPP + (size_t)(s * 15 + i) * 1024 : O_NPS + (size_t)((s - 16) * 15 + i) * 1024);
        const bf16* sp = A_Z(A) + (size_t)src * LDZ + ZU;
#pragma unroll
        for (int j = 0; j < 2; ++j) { const int c = 8 * F.lane + 512 * j; const v4u w4 = *(const v4u*)(sp + c);
            *(f32x4*)(dst + c) = (f32x4){bflo(w4.x), bfhi(w4.x), bflo(w4.y), bfhi(w4.y)}; *(f32x4*)(dst + c + 4) = (f32x4){bflo(w4.z), bfhi(w4.z), bflo(w4.w), bfhi(w4.w)}; }
    }
}

constexpr int GL_GLRB = 0, GL_WGT = 2048, GL_BIAS = 6144, GL_GTOT = 6656, GL_DEXP = 7680, GL_PART = 8192, GL_GG = 10240, GL_QT = 11264, GL_KT = 28672, GL_OI = GL_QT, GL_VT = 46080, GL_VR = 82944, GL_KDT = GL_VR, GL_PP = GL_VR + 18432, GL_END = GL_VR + 33792;
static_assert(GL_END <= 131072 && GL_PP + 9216 <= GL_END && GL_OI + 64 * 264 * 2 <= GL_VT, "GLA LDS map");
template <bool SO>
__device__ __forceinline__ void gla_unit(Frame& F, const Args& A, int row0, int nchunk, int h, int nprev, const float* sprev, const float* bprev, bool raws, float* Sout, float* Bout) {
    LAS unsigned char* lds = F.lds;
    LAS unsigned char* GLRB = lds + GL_GLRB; LAS unsigned char* WGT = lds + GL_WGT; LAS float* BIAS = (LAS float*)(lds + GL_BIAS); LAS float* GTOT = (LAS float*)(lds + GL_GTOT);
    LAS float* DEXP = (LAS float*)(lds + GL_DEXP); LAS float* PART = (LAS float*)(lds + GL_PART); LAS float* GG = (LAS float*)(lds + GL_GG);
    LAS unsigned char* QT = lds + GL_QT; LAS unsigned char* KT = lds + GL_KT; LAS unsigned char* OI = lds + GL_OI; LAS unsigned char* KDT = lds + GL_KDT; LAS unsigned char* VT = lds + GL_VT; LAS unsigned char* PP = lds + GL_PP; LAS unsigned char* VR = lds + GL_VR;
    const int wid = F.wave;
    const bf16* Z = A_Z(A);
    { const int tid = F.tid, k = tid & 127, r4 = tid >> 7; const float* wp = A_WGU(A) + (size_t)(4 * r4) * 512 + h * 128 + k;
      *(LAS v2u*)(WGT + (k * 16 + 4 * r4) * 2) = (v2u){pk2(wp[0], wp[512]), pk2(wp[1024], wp[1536])};
      if (tid < 128) BIAS[tid] = A_BGU(A)[h * 128 + tid];
      if (tid < 256) GG[tid] = A_GGO(A)[tid]; }
    f32x16 S[4];
#pragma unroll
    for (int kb = 0; kb < 4; ++kb)
#pragma unroll
        for (int r = 0; r < 16; ++r) S[kb][r] = 0.f;
    for (int p = 0; p < nprev; ++p) { int ln = F.lane; OPQ(ln); const int hh = ln >> 5, l31 = ln & 31; const float* sp = sprev + (size_t)p * 32768; const float* bp = bprev + (size_t)p * 128;
        if (raws) {
#pragma unroll
            for (int kb = 0; kb < 4; ++kb)
#pragma unroll
                for (int r = 0; r < 16; ++r) { const int k = 32 * kb + (r & 3) + 8 * (r >> 2) + 4 * hh; S[kb][r] = sp[(size_t)k * 256 + 32 * wid + l31]; }
        } else {
#pragma unroll
            for (int kb = 0; kb < 4; ++kb)
#pragma unroll
                for (int g = 0; g < 4; ++g) { const f32x4 sv = *(const f32x4*)(sp + (size_t)(((wid * 4 + kb) * 4 + g) * 64 + ln) * 4); const f32x4 bv = *(const f32x4*)(bp + 32 * kb + 8 * g + 4 * hh);
                    S[kb][4 * g + 0] = S[kb][4 * g + 0] * __expf(bv.x) + sv.x; S[kb][4 * g + 1] = S[kb][4 * g + 1] * __expf(bv.y) + sv.y; S[kb][4 * g + 2] = S[kb][4 * g + 2] * __expf(bv.z) + sv.z; S[kb][4 * g + 3] = S[kb][4 * g + 3] * __expf(bv.w) + sv.w; }
        } }
    float bsum = 0.f;
    v4u rq[2], rk[2], rv[4], rg;
#define GLA_LOAD_RAW(zbase) do { int t_ = F.tid; OPQ(t_); \
        _Pragma("unroll") for (int i = 0; i < 2; ++i) { const int idx = t_ + 512 * i, row = idx >> 4, c8 = idx & 15; const unsigned off = (unsigned)((row * LDZ + ZQ + h * 128 + 8 * c8) * 2); if constexpr (!SO) rq[i] = *(const v4u*)((zbase) + off); rk[i] = *(const v4u*)((zbase) + off + (ZK - ZQ) * 2); } \
        _Pragma("unroll") for (int i = 0; i < 4; ++i) { const int idx = t_ + 512 * i, row = idx >> 5, c8 = idx & 31; rv[i] = *(const v4u*)((zbase) + (unsigned)((row * LDZ + ZV + h * 256 + 8 * c8) * 2)); } \
        if (t_ < 128) rg = *(const v4u*)((zbase) + (unsigned)(((t_ >> 1) * LDZ + ZLR + 8 * (t_ & 1)) * 2)); } while (0)
#define GLA_LOAD_QK(zbase) do { int t_ = F.tid; OPQ(t_); \
        _Pragma("unroll") for (int i = 0; i < 2; ++i) { const int idx = t_ + 512 * i, row = idx >> 4, c8 = idx & 15; const unsigned off = (unsigned)((row * LDZ + ZQ + h * 128 + 8 * c8) * 2); if constexpr (!SO) rq[i] = *(const v4u*)((zbase) + off); rk[i] = *(const v4u*)((zbase) + off + (ZK - ZQ) * 2); } \
        if (t_ < 128) rg = *(const v4u*)((zbase) + (unsigned)(((t_ >> 1) * LDZ + ZLR + 8 * (t_ & 1)) * 2)); } while (0)
#define GLA_LDV4(p) (SO ? __builtin_nontemporal_load(p) : *(p))
#define GLA_LD_K(i, zbase) do { int t_ = F.tid; OPQ(t_); const int idx = t_ + 512 * (i), row = idx >> 4, c8 = idx & 15; __builtin_amdgcn_sched_barrier(0); rk[i] = GLA_LDV4((const v4u*)((zbase) + (unsigned)((row * LDZ + ZK + h * 128 + 8 * c8) * 2))); __builtin_amdgcn_sched_barrier(0); } while (0)
#define GLA_LD_Q(i, zbase) do { int t_ = F.tid; OPQ(t_); const int idx = t_ + 512 * (i), row = idx >> 4, c8 = idx & 15; __builtin_amdgcn_sched_barrier(0); rq[i] = *(const v4u*)((zbase) + (unsigned)((row * LDZ + ZQ + h * 128 + 8 * c8) * 2)); __builtin_amdgcn_sched_barrier(0); } while (0)
#define GLA_LD_G(zbase) do { int t_ = F.tid; OPQ(t_); __builtin_amdgcn_sched_barrier(0); if (t_ < 128) rg = GLA_LDV4((const v4u*)((zbase) + (unsigned)(((t_ >> 1) * LDZ + ZLR + 8 * (t_ & 1)) * 2))); __builtin_amdgcn_sched_barrier(0); } while (0)
#define GLA_LD_V(i, zbase) do { int t_ = F.tid; OPQ(t_); const int idx = t_ + 512 * (i), row = idx >> 5, c8 = idx & 31; __builtin_amdgcn_sched_barrier(0); rv[i] = GLA_LDV4((const v4u*)((zbase) + (unsigned)((row * LDZ + ZV + h * 256 + 8 * c8) * 2))); __builtin_amdgcn_sched_barrier(0); } while (0)
#define GLA_LD_S(n, zbase) do { int t_ = F.tid; OPQ(t_); const int idx = t_ + 512 * (n), row = idx >> 5, c8 = idx & 31; __builtin_amdgcn_sched_barrier(0); sgv[n] = *(const v4u*)((zbase) + (unsigned)((row * LDZ + ZGG + h * 256 + 8 * c8) * 2)); __builtin_amdgcn_sched_barrier(0); } while (0)
#define GLA_LOAD_V(zbase) do { int t_ = F.tid; OPQ(t_); \
        _Pragma("unroll") for (int i = 0; i < 4; ++i) { const int idx = t_ + 512 * i, row = idx >> 5, c8 = idx & 31; rv[i] = *(const v4u*)((zbase) + (unsigned)((row * LDZ + ZV + h * 256 + 8 * c8) * 2)); } } while (0)
    { const char* z0 = (const char*)Z + (size_t)row0 * (LDZ * 2); GLA_LOAD_RAW(z0); }
    __syncthreads();

    for (int c = 0; c < nchunk; ++c) {
        const char* zc = (const char*)Z + (size_t)(row0 + 64 * c) * (LDZ * 2);
        { int tid = F.tid; OPQ(tid);
#pragma unroll
          for (int i = 0; i < 2; ++i) { const int idx = tid + 512 * i, row = idx >> 4, c8 = idx & 15; if constexpr (!SO) *(LAS v4u*)(QT + (row * 136 + 8 * c8) * 2) = rq[i]; *(LAS v4u*)(KT + (row * 136 + 8 * c8) * 2) = rk[i]; }
#pragma unroll
          for (int i = 0; i < 4; ++i) { const int idx = tid + 512 * i, row = idx >> 5, c8 = idx & 31; *(LAS v4u*)(VR + (row * 264 + 8 * c8) * 2) = rv[i]; }
          if (tid < 128) *(LAS v4u*)(GLRB + tid * 16) = rg; }
        __syncthreads();
        const bool nx = c + 1 < nchunk; const char* zn = zc + (size_t)64 * (LDZ * 2);
        if (nx) GLA_LD_G(zn);
        v4u sgv[4];
        { int tid = F.tid; OPQ(tid); const int vv = tid & 255, jh = tid >> 8;
#pragma unroll
          for (int q = 0; q < 4; ++q) { unsigned e[8];
#pragma unroll
              for (int x = 0; x < 8; ++x) e[x] = *(const LAS unsigned short*)(VR + ((32 * jh + 8 * q + x) * 264 + vv) * 2);
              *(LAS v4u*)(VT + (vv * 72 + 32 * jh + 8 * q) * 2) = (v4u){e[0] | (e[1] << 16), e[2] | (e[3] << 16), e[4] | (e[5] << 16), e[6] | (e[7] << 16)}; } }
        float pb[16];
        { int lane = F.lane; OPQ(lane); const int hh = lane >> 5, l31 = lane & 31; const int kb = wid & 3, jb = wid >> 2, k = 32 * kb + l31;
          const bf16x8 ga = *(const LAS bf16x8*)(GLRB + ((32 * jb + l31) * 16 + 8 * hh) * 2);
          const bf16x8 wb = *(const LAS bf16x8*)(WGT + (k * 16 + 8 * hh) * 2);
          f32x16 d;
#pragma unroll
          for (int r = 0; r < 16; ++r) d[r] = 0.f;
          d = __builtin_amdgcn_mfma_f32_32x32x16_bf16(ga, wb, d, 0, 0, 0);
          const float bias = BIAS[k];
          float gs[4], pgs[4];
#pragma unroll
          for (int g = 0; g < 4; ++g) { float run = 0.f;
              if (nx) { if (g == 0) GLA_LD_K(0, zn); else if (g == 1) GLA_LD_K(1, zn); else if constexpr (!SO) { if (g == 2) GLA_LD_Q(0, zn); else GLA_LD_Q(1, zn); } }
#pragma unroll
              for (int e = 0; e < 4; ++e) { const float a = d[4 * g + e] + bias; const float la = (fminf(a, 0.f) - __logf(1.0f + __expf(-fabsf(a)))) * (1.0f / 16.0f); run += la; pb[4 * g + e] = run; }
              gs[g] = run; }
#pragma unroll
          for (int g = 0; g < 4; ++g) pgs[g] = __shfl_xor(gs[g], 32);
          float offs = 0.f;
#pragma unroll
          for (int g = 0; g < 4; ++g) { const float mine = offs + (hh ? pgs[g] : 0.f);
#pragma unroll
              for (int e = 0; e < 4; ++e) pb[4 * g + e] += mine;
              offs += gs[g] + pgs[g]; }
          if (hh == 0) GTOT[jb * 128 + k] = offs; }
        __syncthreads();
        { int lane = F.lane; OPQ(lane); const int hh = lane >> 5, l31 = lane & 31; const int kb = wid & 3, jb = wid >> 2, k = 32 * kb + l31;
          const float t0 = GTOT[k], t1 = GTOT[128 + k]; const float bend = t0 + t1, joff = jb ? t0 : 0.f; const float ebend = __expf(bend);
          bsum += bend;
#pragma unroll
          for (int g = 0; g < 4; ++g) { float kdv[4];
              if (nx) { if (g == 0) GLA_LD_V(0, zn); else if (g == 1) GLA_LD_V(1, zn); else if (g == 2) GLA_LD_V(2, zn); else GLA_LD_V(3, zn); }
#pragma unroll
              for (int e = 0; e < 4; ++e) { const int j = 32 * jb + 8 * g + 4 * hh + e; const float b = pb[4 * g + e] + joff;
                  LAS unsigned short* kp = (LAS unsigned short*)(KT + (j * 136 + k) * 2); const float kk = bf2f(*kp);
                  if constexpr (!SO) { LAS unsigned short* qp = (LAS unsigned short*)(QT + (j * 136 + k) * 2); const float q = bf2f(*qp);
                      const float qt = q * __expf(b), kt = kk * __expf(-b); kdv[e] = kt * ebend;
                      const unsigned w = pg8::cvt_pk_bf16(qt, kt); *qp = (unsigned short)w; *kp = (unsigned short)(w >> 16); }
                  else kdv[e] = kk * __expf(bend - b); }
              *(LAS v2u*)(KDT + (k * 72 + 32 * jb + 8 * g + 4 * hh) * 2) = (v2u){pg8::cvt_pk_bf16(kdv[0], kdv[1]), pg8::cvt_pk_bf16(kdv[2], kdv[3])}; }
          if (jb == 0 && hh == 0) DEXP[k] = ebend; }
        __syncthreads();
        f32x16 o[2];
        if constexpr (!SO) {
        if (wid < 3) { int lane = F.lane; OPQ(lane); const int hh = lane >> 5, l31 = lane & 31;
            const int jb = (wid == 2) ? 1 : 0, ib = (wid >= 1) ? 1 : 0;
            f32x16 sc;
#pragma unroll
            for (int r = 0; r < 16; ++r) sc[r] = 0.f;
#pragma unroll
            for (int s = 0; s < 8; ++s) { const bf16x8 a = *(const LAS bf16x8*)(KT + ((32 * jb + l31) * 136 + 16 * s + 8 * hh) * 2); const bf16x8 bq = *(const LAS bf16x8*)(QT + ((32 * ib + l31) * 136 + 16 * s + 8 * hh) * 2);
                sc = __builtin_amdgcn_mfma_f32_32x32x16_bf16(a, bq, sc, 0, 0, 0); }
            const int i = 32 * ib + l31;
#pragma unroll
            for (int g = 0; g < 4; ++g) { const int j0 = 32 * jb + 8 * g + 4 * hh; float v[4];
#pragma unroll
                for (int e = 0; e < 4; ++e) v[e] = (i >= j0 + e) ? sc[4 * g + e] : 0.f;
                *(LAS v2u*)(PP + (i * 72 + j0) * 2) = (v2u){pg8::cvt_pk_bf16(v[0], v[1]), pg8::cvt_pk_bf16(v[2], v[3])}; } }
        { int lane = F.lane; OPQ(lane); const int hh = lane >> 5, l31 = lane & 31;
#pragma unroll
          for (int ib = 0; ib < 2; ++ib)
#pragma unroll
            for (int r = 0; r < 16; ++r) o[ib][r] = 0.f;
#pragma unroll
          for (int kb = 0; kb < 4; ++kb) {
            if (kb == 0) GLA_LD_S(0, zc); else if (kb == 1) GLA_LD_S(1, zc); else if (kb == 2) GLA_LD_S(2, zc); else GLA_LD_S(3, zc);
#pragma unroll
            for (int s = 0; s < 2; ++s) {
                v4u af; af.x = pg8::cvt_pk_bf16(S[kb][8 * s + 0], S[kb][8 * s + 1]); af.y = pg8::cvt_pk_bf16(S[kb][8 * s + 2], S[kb][8 * s + 3]); af.z = pg8::cvt_pk_bf16(S[kb][8 * s + 4], S[kb][8 * s + 5]); af.w = pg8::cvt_pk_bf16(S[kb][8 * s + 6], S[kb][8 * s + 7]);
                const bf16x8 a = __builtin_bit_cast(bf16x8, af);
#pragma unroll
                for (int ib = 0; ib < 2; ++ib) { const LAS unsigned char* qp = QT + ((32 * ib + l31) * 136 + 32 * kb + 16 * s + 4 * hh) * 2;
                    const v2u lo = *(const LAS v2u*)qp, hi = *(const LAS v2u*)(qp + 16);
                    const bf16x8 bq = __builtin_bit_cast(bf16x8, ((v4u){lo.x, lo.y, hi.x, hi.y}));
                    o[ib] = __builtin_amdgcn_mfma_f32_32x32x16_bf16(a, bq, o[ib], 0, 0, 0); } } } }
        __syncthreads();
        { int lane = F.lane; OPQ(lane); const int hh = lane >> 5, l31 = lane & 31;
#pragma unroll
          for (int s = 0; s < 4; ++s) { const bf16x8 a = *(const LAS bf16x8*)(VT + ((32 * wid + l31) * 72 + 16 * s + 8 * hh) * 2);
            if (s < 2) { const bf16x8 b0 = *(const LAS bf16x8*)(PP + (l31 * 72 + 16 * s + 8 * hh) * 2); o[0] = __builtin_amdgcn_mfma_f32_32x32x16_bf16(a, b0, o[0], 0, 0, 0); }
            const bf16x8 b1 = *(const LAS bf16x8*)(PP + ((32 + l31) * 72 + 16 * s + 8 * hh) * 2); o[1] = __builtin_amdgcn_mfma_f32_32x32x16_bf16(a, b1, o[1], 0, 0, 0); }
#pragma unroll
          for (int ib = 0; ib < 2; ++ib) { float ss = 0.f;
#pragma unroll
            for (int r = 0; r < 16; ++r) ss += o[ib][r] * o[ib][r];
            ss += __shfl_xor(ss, 32);
            if (hh == 0) PART[wid * 64 + 32 * ib + l31] = ss; } }
        }
        { int lane = F.lane; OPQ(lane); const int hh = lane >> 5, l31 = lane & 31;
#pragma unroll
          for (int kb = 0; kb < 4; ++kb) {
#pragma unroll
            for (int g = 0; g < 4; ++g) { const f32x4 d4 = *(const LAS f32x4*)(DEXP + 32 * kb + 8 * g + 4 * hh);
                S[kb][4 * g + 0] *= d4.x; S[kb][4 * g + 1] *= d4.y; S[kb][4 * g + 2] *= d4.z; S[kb][4 * g + 3] *= d4.w; }
#pragma unroll
            for (int s = 0; s < 4; ++s) { const bf16x8 a = *(const LAS bf16x8*)(KDT + ((32 * kb + l31) * 72 + 16 * s + 8 * hh) * 2); const bf16x8 bv = *(const LAS bf16x8*)(VT + ((32 * wid + l31) * 72 + 16 * s + 8 * hh) * 2);
                S[kb] = __builtin_amdgcn_mfma_f32_32x32x16_bf16(a, bv, S[kb], 0, 0, 0); } } }
        if constexpr (!SO) {
        __syncthreads();
        { int lane = F.lane; OPQ(lane); const int hh = lane >> 5, l31 = lane & 31;
#pragma unroll
          for (int ib = 0; ib < 2; ++ib) { float tot = 0.f;
#pragma unroll
            for (int w8 = 0; w8 < 8; ++w8) tot += PART[w8 * 64 + 32 * ib + l31];
            const float rinv = __builtin_amdgcn_rsqf(tot * (1.0f / 256.0f) + EPS);
#pragma unroll
            for (int g = 0; g < 4; ++g) { const f32x4 g4 = *(const LAS f32x4*)(GG + 32 * wid + 8 * g + 4 * hh);
                *(LAS v2u*)(OI + ((32 * ib + l31) * 264 + 32 * wid + 8 * g + 4 * hh) * 2) = (v2u){pg8::cvt_pk_bf16(o[ib][4 * g + 0] * rinv * g4.x, o[ib][4 * g + 1] * rinv * g4.y), pg8::cvt_pk_bf16(o[ib][4 * g + 2] * rinv * g4.z, o[ib][4 * g + 3] * rinv * g4.w)}; } } }
        __syncthreads();
        { int tid = F.tid; OPQ(tid);
#pragma unroll
          for (int n = 0; n < 4; ++n) { const int idx = tid + 512 * n, row = idx >> 5, c8 = idx & 31; const v4u ov = *(const LAS v4u*)(OI + (row * 264 + 8 * c8) * 2); const v4u gv = sgv[n];
              v4u y; y.x = pg8::cvt_pk_bf16(bflo(ov.x) * bflo(gv.x), bfhi(ov.x) * bfhi(gv.x)); y.y = pg8::cvt_pk_bf16(bflo(ov.y) * bflo(gv.y), bfhi(ov.y) * bfhi(gv.y));
              y.z = pg8::cvt_pk_bf16(bflo(ov.z) * bflo(gv.z), bfhi(ov.z) * bfhi(gv.z)); y.w = pg8::cvt_pk_bf16(bflo(ov.w) * bflo(gv.w), bfhi(ov.w) * bfhi(gv.w));
              *(v4u*)((char*)zc + (unsigned)((row * LDZ + ZGG + h * 256 + 8 * c8) * 2)) = y; } }
        }
        __syncthreads();
    }
#undef GLA_LOAD_RAW
#undef GLA_LOAD_QK
#undef GLA_LOAD_V
#undef GLA_LDV4
#undef GLA_LD_K
#undef GLA_LD_Q
#undef GLA_LD_G
#undef GLA_LD_V
#undef GLA_LD_S
    if (Sout) { int ln = F.lane; OPQ(ln); const int hh = ln >> 5, l31 = ln & 31;
      if constexpr (SO) {
#pragma unroll
        for (int kb = 0; kb < 4; ++kb)
#pragma unroll
          for (int g = 0; g < 4; ++g) *(f32x4*)(Sout + (size_t)(((wid * 4 + kb) * 4 + g) * 64 + ln) * 4) = (f32x4){S[kb][4 * g + 0], S[kb][4 * g + 1], S[kb][4 * g + 2], S[kb][4 * g + 3]};
      } else {
#pragma unroll
        for (int kb = 0; kb < 4; ++kb)
#pragma unroll
          for (int r = 0; r < 16; ++r) { const int k = 32 * kb + (r & 3) + 8 * (r >> 2) + 4 * hh; Sout[(size_t)k * 256 + 32 * wid + l31] = S[kb][r]; } } }
    if (Bout && wid < 4 && F.lane < 32) Bout[32 * wid + F.lane] = bsum;
    __syncthreads();
}

__global__ void __launch_bounds__(NWAVES * 64, 2) mk_fwd(Args A) {
    extern __shared__ __attribute__((aligned(16))) unsigned char lds[];
    Frame F;
    F.lds = (LAS unsigned char*)lds;
    F.tid = threadIdx.x; F.lane = F.tid & 63; F.wave = __builtin_amdgcn_readfirstlane(F.tid >> 6); F.G = gridDim.x;
#define REFRESH_F() do { int t_ = threadIdx.x; OPQ(t_); F.tid = t_; F.lane = t_ & 63; } while (0)
    const int lo = A.ph_lo, hi = A.ph_hi;
#ifndef PHASE_MASK
#define PHASE_MASK 63
#endif
#ifndef REPEAT_MASK
#define REPEAT_MASK 0
#endif
#define REP(k) (((REPEAT_MASK >> (k)) & 1) ? 2 : 1)
#define IN(k) (((PHASE_MASK >> (k)) & 1) && lo <= (k) && (k) < hi)
#define BOTH(k) (IN(k) && IN((k) + 1))
#if MK_N_LAUNCHES == 1
    for (int u = F.tid; u < (LDS_BYTES - LDSCTL_OFF) / 4; u += NWAVES * 64) ((LAS unsigned*)(F.lds + LDSCTL_OFF))[u] = 0u;
    __syncthreads();
    const XcdBarrier bar = xcd_barrier_post((unsigned*)(A.ws + WS_CTL) + CW_BAR, (volatile LAS unsigned*)(F.lds + MISC_OFF) + 8);
#define GRID_BAR0() xcd_barrier(bar)
#define GRID_BAR() xcd_barrier(bar)
#else
#define GRID_BAR0() do {} while (0)
#define GRID_BAR() do {} while (0)
#endif
    if (IN(0)) { for (int rep = 0; rep < REP(0); ++rep) p0_prologue(F, A); if (BOTH(0)) GRID_BAR0(); }
    if (IN(1)) for (int rep = 0; rep < REP(1); ++rep) {
        pg8::Gemm g{A_XN(A), A_WINT(A), DM, DM, DM, 0}; pg8::StaticOrder S; S.init(NM, NINP / 256, F.G, (int)blockIdx.x);
        EpiZ E{A_Z(A), A_PSCALE(A)};
        pg8::gemm_phase<EpiZ, pg8::StaticOrder, true>(F.lds, g, S, E);
        REFRESH_F();
        if (BOTH(1)) GRID_BAR();
    }
    if (IN(3)) {
        float* SLOC = (float*)(A.ws + WS_SLOC); float* BSEG = (float*)(A.ws + WS_BSEG);
        newpool_copy(F, A);
        const int G = F.G, blk = (int)blockIdx.x;
        const bool pool_first = blk < 192 && (blk & 1);
#define P3A_GLA() do { for (int u = blk; u < 256; u += G) { \
                if (u < 192) { const int b = u / 12, h = (u % 12) / 3, seg = u % 3; \
                    gla_unit<true>(F, A, b * TP + seg * 512, 8, h, 0, nullptr, nullptr, false, SLOC + (size_t)u * 32768, BSEG + (size_t)u * 128); } \
                else { const int us = u - 192, b = us >> 2, h = us & 3; \
                    gla_unit<false>(F, A, MP + b * TS, 1, h, 1, A_SGLA(A) + (size_t)us * 32768, A_BGU(A), true, A.out + O_NGS + (size_t)us * 32768, nullptr); } } } while (0)
#define P3A_POOL() do { int ub, ue; if (blk < 192) { ub = (blk >> 6) * 256 + (blk & 63) * 4; ue = ub + 4; } else { const int k = blk - 192; if (k < 56) { ub = 768 + (k < 32 ? 5 * k : 160 + 4 * (k - 32)); ue = ub + (k < 32 ? 5 : 4); } else { ub = 1024 + 4 * (k - 56); ue = ub + 4; } } \
            if (G == 256) pool_run(F, A, ub, ue); else if (blk == 0) pool_run(F, A, 0, NM * 8); REFRESH_F(); } while (0)
        if (pool_first) { P3A_POOL(); P3A_GLA(); } else { P3A_GLA(); P3A_POOL(); }
#undef P3A_GLA
#undef P3A_POOL
        REFRESH_F();
        GRID_BAR();
        if ((blk & 3) == 0) {
            const int q = blk >> 2, ks = q & 3;
            pg8::Gemm g{A_Z(A) + ZGP + 512 * ks, A_WOUTT(A) + 512 * ks, LDZ, 2048, 512, 0}; OneUnit S1{128 + (q >> 4), (q >> 2) & 3};
            EpiSlab E{(float*)(A.ws + WS_SLAB) + (size_t)q * 65536};
            pg8::gemm_phase<EpiSlab, OneUnit, true>(F.lds, g, S1, E); REFRESH_F(); }
        for (int u = blk; u < 256; u += G) { const int b = u >> 4, h = (u >> 2) & 3, seg = u & 3; const int sl = (b * 4 + h) * 3;
            gla_unit<false>(F, A, b * TP + seg * 512, 8, h, seg, SLOC + (size_t)sl * 32768, BSEG + (size_t)sl * 128, false, seg == 3 ? A.out + O_NGP + (size_t)(b * 4 + h) * 32768 : nullptr, nullptr); }
        if (BOTH(3)) GRID_BAR();
    }
    if (IN(4)) {
        { const int gw = blockIdx.x * NWAVES + F.wave;
          if (gw < MS) { const int r = gw, pnl = r >> 8, rt = r & 255; const float* slab = (const float*)(A.ws + WS_SLAB);
            f32x4 raw[4]; float s2 = 0.f;
#pragma unroll
            for (int pn = 0; pn < 4; ++pn) { f32x4 a = (f32x4){0.f, 0.f, 0.f, 0.f};
#pragma unroll
                for (int ks = 0; ks < 4; ++ks) a = a + *(const f32x4*)(slab + (size_t)(((pnl * 4 + pn) * 4 + ks)) * 65536 + rt * 256 + 4 * F.lane);
                raw[pn] = a; s2 += (a.x * a.x + a.y * a.y) + (a.z * a.z + a.w * a.w); }
            const float rinv = 1.0f / sqrtf(wave_sum(s2) * (1.f / DM) + EPS);
#pragma unroll
            for (int pn = 0; pn < 4; ++pn) { const int c = pn * 256 + 4 * F.lane; const f32x4 xv = *(const f32x4*)(A_XS(A) + (size_t)r * DM + c), gp = *(const f32x4*)(A_GPOST(A) + c);
                *(f32x4*)(A.out + (size_t)(MP + r) * DM + c) = xv + raw[pn] * rinv * gp; } } }
        pg8::Gemm g{A_Z(A) + ZGP, A_WOUTT(A), LDZ, 2048, 2048, 0}; PanelOrder S{(int)blockIdx.x, 128};
        EpiRmsRes E{A_XP(A), A_XS(A), A_GPOST(A), A.out, A_PART(A), (unsigned*)(A.ws + WS_CTL) + CW_CNT, F.lds};
        pg8::gemm_phase<EpiRmsRes, PanelOrder, true>(F.lds, g, S, E);
    }
#undef IN
#undef BOTH
}

extern "C" void kernel_launch(void* const* d_in, const int* in_sizes, int n_in, void* d_out, int out_size, void* d_ws, size_t ws_size, hipStream_t stream) {
    static int grid = 0;
    if (grid == 0) {
        if (n_in != 13 || in_sizes[0] != MP * DM || (size_t)out_size != O_END || ws_size < WS_END) {
            fprintf(stderr, "kernel_launch: unexpected shapes: n_in %d in0 %d out %d ws %zu (need %zu)\n", n_in, n_in > 0 ? in_sizes[0] : -1, out_size, ws_size, (size_t)WS_END); grid = -1; return; }
        int dev = 0, cus = 0, per_cu = 0;
        if (hipGetDevice(&dev) != hipSuccess || hipDeviceGetAttribute(&cus, hipDeviceAttributeMultiprocessorCount, dev) != hipSuccess) { grid = -1; return; }
        if (hipFuncSetAttribute((const void*)mk_fwd, hipFuncAttributeMaxDynamicSharedMemorySize, LDS_BYTES) != hipSuccess) { fprintf(stderr, "kernel_launch: hipFuncSetAttribute failed\n"); grid = -1; return; }
        if (hipOccupancyMaxActiveBlocksPerMultiprocessor(&per_cu, (const void*)mk_fwd, NWAVES * 64, LDS_BYTES) != hipSuccess || per_cu < 1) { fprintf(stderr, "kernel_launch: occupancy query failed (%d)\n", per_cu); (void)hipGetLastError(); grid = -1; return; }
        if (cus != 256) { fprintf(stderr, "kernel_launch: built for a 256-CU device (got %d)\n", cus); grid = -1; return; }
        grid = cus;
    }
    if (grid < 0) return;
    (void)hipMemsetAsync((char*)d_ws + WS_CTL, 0, CTL_ZERO_BYTES, stream);
    Args a{};
    for (int i = 0; i < 13; ++i) a.in[i] = (const float*)d_in[i];
    a.out = (float*)d_out; a.ws = (unsigned char*)d_ws;
#if MK_N_LAUNCHES == 1
    a.ph_lo = 0; a.ph_hi = 6;
    void* kargs[] = {&a};
    hipError_t e = hipLaunchCooperativeKernel((const void*)mk_fwd, dim3(grid), dim3(NWAVES * 64), kargs, LDS_BYTES, stream);
    if (e != hipSuccess) fprintf(stderr, "cooperative launch failed: %s (grid %d)\n", hipGetErrorString(e), grid);
#else
    for (int li = 0; li < 6; ++li) { a.ph_lo = li; a.ph_hi = li + 1; hipLaunchKernelGGL(mk_fwd, dim3(grid), dim3(NWAVES * 64), LDS_BYTES, stream, a); }
#endif
}
```
